# Optimizing an MI355X kernel written in HIP

```python
import jax
import jax.numpy as jnp
from jax import lax
import numpy as np

D_MODEL = 1024
BATCH = 8
SEQ = 4096
DEPTH = 2

HEAD_DIM = 64
BRANCH_WIDTH = 256
N_BRANCH = 4
HG_HEADS = 4
HG_CHUNK = 16
LB_FLOOR = 1e-30
RET_HEADS = 4
RET_CHUNK = 64
ATT_HEADS = 4
ATT_KV_HEADS = 2
ATT_GROUP = ATT_HEADS // ATT_KV_HEADS
WINDOW = 128
ATT_BLOCK = 128
MASK_VALUE = -1e30
LRU_WIDTH = 256
LRU_BLOCKS = 4
LRU_BLOCK_DIM = LRU_WIDTH // LRU_BLOCKS
CONV_WIDTH = 4
LRU_C = 8.0
D_FF = 2816
EPS = 1e-6

IN_SIZES = (
    BRANCH_WIDTH, BRANCH_WIDTH, BRANCH_WIDTH, BRANCH_WIDTH,
    BRANCH_WIDTH, BRANCH_WIDTH, BRANCH_WIDTH, BRANCH_WIDTH,
    ATT_HEADS * HEAD_DIM, ATT_KV_HEADS * HEAD_DIM, ATT_KV_HEADS * HEAD_DIM,
    LRU_WIDTH, LRU_WIDTH,
    N_BRANCH * D_MODEL,
)
D_IN = sum(IN_SIZES)

kernel_name = "hybrid_hgrn2_retnet_swa_rglru_macaron"


def _rmsnorm(x, w):
    xf = x.astype(jnp.float32)
    y = xf * lax.rsqrt(jnp.mean(xf * xf, axis=-1, keepdims=True) + EPS)
    return (y * w.astype(jnp.float32)).astype(x.dtype)


def _swiglu(x, wg, wu, wd):
    return (jax.nn.silu(x @ wg) * (x @ wu)) @ wd


def _split_cols(t, sizes):
    out, start = [], 0
    for s in sizes:
        out.append(t[..., start:start + s])
        start += s
    return out


def _to_chunks(t, n_heads, chunk):
    B, T, _ = t.shape
    return t.reshape(B, T // chunk, chunk, n_heads, -1).transpose(0, 3, 1, 2, 4)


def _from_chunks(o):
    B, H, N, C, d = o.shape
    return o.transpose(0, 2, 3, 1, 4).reshape(B, N * C, H * d)


def _chunk_state_scan(decay, dS):
    def step(S, inp):
        dec, ds = inp
        return dec[..., None] * S + ds, S
    S0 = jnp.zeros_like(dS[:, :, 0])
    _, S_start = lax.scan(step, S0, (jnp.moveaxis(decay, 2, 0), jnp.moveaxis(dS, 2, 0)))
    return jnp.moveaxis(S_start, 0, 2)


def _hgrn2(q, f_pre, i, g, lb, out_w):
    B, T, _ = q.shape
    H, d, C = HG_HEADS, HEAD_DIM, HG_CHUNK
    dtype = q.dtype
    z = f_pre.astype(jnp.float32)
    lb = lb.astype(jnp.float32)
    log_f = jnp.logaddexp(jnp.log(jnp.maximum(lb, LB_FLOOR)), jnp.log1p(-lb) + jax.nn.log_sigmoid(z))
    k = (1.0 - lb) * jax.nn.sigmoid(-z)
    qc = _to_chunks(q.astype(jnp.float32), H, C)
    kc = _to_chunks(k, H, C)
    vc = _to_chunks(i.astype(jnp.float32), H, C)
    b = jnp.cumsum(_to_chunks(log_f, H, C), axis=3)
    b_ref = b[:, :, :, C // 2:C // 2 + 1]
    qt = qc * jnp.exp(b - b_ref)
    kt = kc * jnp.exp(b_ref - b)
    causal = jnp.tril(jnp.ones((C, C), dtype=bool))
    att = jnp.where(causal, jnp.einsum('bhntk,bhnsk->bhnts', qt, kt), 0.0)
    o = jnp.einsum('bhnts,bhnsv->bhntv', att, vc)
    b_last = b[:, :, :, -1:]
    dS = jnp.einsum('bhnsk,bhnsv->bhnkv', kc * jnp.exp(b_last - b), vc)
    S_start = _chunk_state_scan(jnp.exp(b_last[:, :, :, 0]), dS)
    o = o + jnp.einsum('bhntk,bhnkv->bhntv', qc * jnp.exp(b), S_start)
    o = _from_chunks(o).reshape(B, T, H, d)
    o = _rmsnorm(o, out_w.reshape(H, d)) * jax.nn.sigmoid(g.astype(jnp.float32)).reshape(B, T, H, d)
    return o.reshape(B, T, H * d).astype(dtype)


def _retention(q, k, v, g, gn_w, gn_b):
    B, T, _ = q.shape
    H, d, C = RET_HEADS, HEAD_DIM, RET_CHUNK
    N = T // C
    dtype = q.dtype
    log_gamma = jnp.log1p(-jnp.exp2(-5.0 - jnp.arange(H, dtype=jnp.float32)))
    qc = _to_chunks(q.astype(jnp.float32), H, C) * d ** -0.5
    kc = _to_chunks(k.astype(jnp.float32), H, C)
    vc = _to_chunks(v.astype(jnp.float32), H, C)
    pos = jnp.arange(C, dtype=jnp.float32)
    rel = pos[:, None] - pos[None, :]
    decay = jnp.where(rel >= 0, jnp.exp(log_gamma[:, None, None] * jnp.maximum(rel, 0.0)), 0.0)
    att = jnp.einsum('bhntk,bhnsk->bhnts', qc, kc) * decay[None, :, None]
    o = jnp.einsum('bhnts,bhnsv->bhntv', att, vc)
    lg = log_gamma[None, :, None, None, None]
    dS = jnp.einsum('bhnsk,bhnsv->bhnkv', kc * jnp.exp(lg * (C - 1.0 - pos)[:, None]), vc)
    chunk_decay = jnp.broadcast_to(jnp.exp(log_gamma * C)[None, :, None, None], (B, H, N, d))
    S_start = _chunk_state_scan(chunk_decay, dS)
    o = o + jnp.einsum('bhntk,bhnkv->bhntv', qc * jnp.exp(lg * (pos + 1.0)[:, None]), S_start)
    o = _from_chunks(o).reshape(B, T, H, d)
    mu = jnp.mean(o, axis=-1, keepdims=True)
    var = jnp.mean(jnp.square(o - mu), axis=-1, keepdims=True)
    o = (o - mu) * lax.rsqrt(var + EPS) * gn_w.astype(jnp.float32).reshape(H, d) + gn_b.astype(jnp.float32).reshape(H, d)
    o = o * jax.nn.silu(g.astype(jnp.float32)).reshape(B, T, H, d)
    return o.reshape(B, T, H * d).astype(dtype)


def _swa(q, k, v, qn_w, kn_w, sinks):
    B, T, _ = q.shape
    Q, KV, G, d = ATT_BLOCK, ATT_KV_HEADS, ATT_GROUP, HEAD_DIM
    N = T // Q
    dtype = q.dtype
    q = _rmsnorm(q.reshape(B, T, KV, G, d), qn_w).astype(jnp.float32)
    k = _rmsnorm(k.reshape(B, T, KV, d), kn_w).astype(jnp.float32)
    v = v.reshape(B, T, KV, d).astype(jnp.float32)
    qb = q.reshape(B, N, Q, KV, G, d)

    def with_prev(t):
        tb = t.reshape(B, N, Q, KV, d)
        prev = jnp.concatenate([jnp.zeros_like(tb[:, :1]), tb[:, :-1]], axis=1)
        return jnp.concatenate([prev, tb], axis=2)

    kw, vw = with_prev(k), with_prev(v)
    s = jnp.einsum('bnqkgd,bnskd->bnkgqs', qb, kw) * d ** -0.5
    dist = jnp.arange(Q)[:, None] + Q - jnp.arange(2 * Q)[None, :]
    valid = (dist >= 0) & (dist < WINDOW)
    valid = valid[None] & ((jnp.arange(N)[:, None, None] > 0) | (jnp.arange(2 * Q)[None, None, :] >= Q))
    slopes = jnp.exp2(-8.0 * jnp.arange(1, ATT_HEADS + 1, dtype=jnp.float32) / ATT_HEADS).reshape(KV, G, 1, 1)
    s = s - slopes * dist.astype(jnp.float32)
    s = jnp.where(valid[None, :, None, None], s, MASK_VALUE)
    sink = jnp.broadcast_to(sinks.astype(jnp.float32).reshape(1, 1, KV, G, 1, 1), s.shape[:-1] + (1,))
    p = jax.nn.softmax(jnp.concatenate([s, sink], axis=-1), axis=-1)[..., :-1]
    o = jnp.einsum('bnkgqs,bnskd->bnqkgd', p, vw)
    return o.reshape(B, T, KV * G * d).astype(dtype)


def _rglru(xb, gb, conv_w, conv_b, wa, ba, wx, bx, lam):
    B, T, W = xb.shape
    dtype = xb.dtype
    xf = xb.astype(jnp.float32)
    xp = jnp.pad(xf, ((0, 0), (CONV_WIDTH - 1, 0), (0, 0)))
    xc = conv_b.astype(jnp.float32)
    for j in range(CONV_WIDTH):
        xc = xc + xp[:, j:j + T] * conv_w[j].astype(jnp.float32)
    xr = xc.reshape(B, T, LRU_BLOCKS, LRU_BLOCK_DIM)
    r = jax.nn.sigmoid(jnp.einsum('btnc,nce->btne', xr, wa.astype(jnp.float32)).reshape(B, T, W) + ba.astype(jnp.float32))
    i = jax.nn.sigmoid(jnp.einsum('btnc,nce->btne', xr, wx.astype(jnp.float32)).reshape(B, T, W) + bx.astype(jnp.float32))
    log_a = -LRU_C * r * jax.nn.softplus(-lam.astype(jnp.float32))
    a = jnp.exp(log_a)
    u = jnp.sqrt(-jnp.expm1(2.0 * log_a)) * (i * xc)

    def combine(left, right):
        a_l, b_l = left
        a_r, b_r = right
        return a_l * a_r, a_r * b_l + b_r

    _, h = lax.associative_scan(combine, (a, u), axis=1)
    y = h * jax.nn.gelu(gb.astype(jnp.float32))
    return y.astype(dtype)


def setup_inputs(seed: int = 0) -> dict:
    key = jax.random.key(seed)
    kit = iter(jax.random.split(key, 40))
    L, D, F, W, bd = DEPTH, D_MODEL, D_FF, BRANCH_WIDTH, LRU_BLOCK_DIM

    def normal(shape, scale):
        return scale * jax.random.normal(next(kit), shape, jnp.float32)

    def gain(shape):
        return 1.0 + normal(shape, 0.02)

    x = normal((BATCH, SEQ, D), 1.0)
    ffn1_norm = gain((L, D))
    ffn1_wg = normal((L, D, F), D ** -0.5)
    ffn1_wu = normal((L, D, F), D ** -0.5)
    ffn1_wd = normal((L, F, D), F ** -0.5)
    mix_norm = gain((L, D))
    w_in = normal((L, D, D_IN), D ** -0.5)
    gate_bias = normal((L, N_BRANCH, D), 0.02)
    hgrn_lb_logits = normal((L, W), 0.5)
    hgrn_out_norm = gain((L, W))
    ret_gn_w = gain((L, W))
    ret_gn_b = normal((L, W), 0.02)
    attn_q_norm = gain((L, HEAD_DIM))
    attn_k_norm = gain((L, HEAD_DIM))
    attn_sinks = normal((L, ATT_HEADS), 1.0)
    lru_conv_w = normal((L, CONV_WIDTH, LRU_WIDTH), CONV_WIDTH ** -0.5)
    lru_conv_b = normal((L, LRU_WIDTH), 0.02)
    lru_wa = normal((L, LRU_BLOCKS, bd, bd), bd ** -0.5)
    lru_ba = normal((L, LRU_WIDTH), 0.02)
    lru_wx = normal((L, LRU_BLOCKS, bd, bd), bd ** -0.5)
    lru_bx = normal((L, LRU_WIDTH), 0.02)
    u = jax.random.uniform(next(kit), (L, LRU_WIDTH), jnp.float32, 0.9, 0.999)
    a0 = u ** (1.0 / LRU_C)
    lru_lambda = jnp.log(a0) - jnp.log1p(-a0)
    w_branch = normal((L, N_BRANCH, W, D), W ** -0.5)
    w_out = normal((L, D, D), D ** -0.5)
    ffn2_norm = gain((L, D))
    ffn2_wg = normal((L, D, F), D ** -0.5)
    ffn2_wu = normal((L, D, F), D ** -0.5)
    ffn2_wd = normal((L, F, D), F ** -0.5)
    return {
        "x": x, "ffn1_norm": ffn1_norm, "ffn1_wg": ffn1_wg, "ffn1_wu": ffn1_wu, "ffn1_wd": ffn1_wd,
        "mix_norm": mix_norm, "w_in": w_in, "gate_bias": gate_bias,
        "hgrn_lb_logits": hgrn_lb_logits, "hgrn_out_norm": hgrn_out_norm,
        "ret_gn_w": ret_gn_w, "ret_gn_b": ret_gn_b,
        "attn_q_norm": attn_q_norm, "attn_k_norm": attn_k_norm, "attn_sinks": attn_sinks,
        "lru_conv_w": lru_conv_w, "lru_conv_b": lru_conv_b, "lru_wa": lru_wa, "lru_ba": lru_ba,
        "lru_wx": lru_wx, "lru_bx": lru_bx, "lru_lambda": lru_lambda,
        "w_branch": w_branch, "w_out": w_out,
        "ffn2_norm": ffn2_norm, "ffn2_wg": ffn2_wg, "ffn2_wu": ffn2_wu, "ffn2_wd": ffn2_wd,
    }


def reference(x, ffn1_norm, ffn1_wg, ffn1_wu, ffn1_wd, mix_norm, w_in, gate_bias,
              hgrn_lb_logits, hgrn_out_norm, ret_gn_w, ret_gn_b,
              attn_q_norm, attn_k_norm, attn_sinks,
              lru_conv_w, lru_conv_b, lru_wa, lru_ba, lru_wx, lru_bx, lru_lambda,
              w_branch, w_out, ffn2_norm, ffn2_wg, ffn2_wu, ffn2_wd):
    B, T, D = x.shape
    lb_p = jax.nn.softmax(hgrn_lb_logits.astype(jnp.float32), axis=0)
    lower_bounds = jnp.cumsum(lb_p, axis=0) - lb_p[0:1]
    for l in range(DEPTH):
        x = x + 0.5 * _swiglu(_rmsnorm(x, ffn1_norm[l]), ffn1_wg[l], ffn1_wu[l], ffn1_wd[l])
        h = _rmsnorm(x, mix_norm[l])
        proj = h @ w_in[l]
        (hq, hf, hi, hg, rq, rk, rv, rg, aq, ak, av, lx, lg, gate_pre) = _split_cols(proj, IN_SIZES)
        y_a = _hgrn2(hq, hf, hi, hg, lower_bounds[l], hgrn_out_norm[l])
        y_b = _retention(rq, rk, rv, rg, ret_gn_w[l], ret_gn_b[l])
        y_c = _swa(aq, ak, av, attn_q_norm[l], attn_k_norm[l], attn_sinks[l])
        y_d = _rglru(lx, lg, lru_conv_w[l], lru_conv_b[l], lru_wa[l], lru_ba[l],
                     lru_wx[l], lru_bx[l], lru_lambda[l])
        gates = jax.nn.sigmoid(gate_pre.astype(jnp.float32).reshape(B, T, N_BRANCH, D)
                               + gate_bias[l].astype(jnp.float32)).astype(x.dtype)
        merged = gates[:, :, 0] * (y_a @ w_branch[l, 0])
        merged = merged + gates[:, :, 1] * (y_b @ w_branch[l, 1])
        merged = merged + gates[:, :, 2] * (y_c @ w_branch[l, 2])
        merged = merged + gates[:, :, 3] * (y_d @ w_branch[l, 3])
        x = x + merged @ w_out[l]
        x = x + 0.5 * _swiglu(_rmsnorm(x, ffn2_norm[l]), ffn2_wg[l], ffn2_wu[l], ffn2_wd[l])
    return x
```

```cpp
#include <hip/hip_runtime.h>
#include <cstdio>
#include <cstdint>

#ifndef MK_MULTI
#define MK_MULTI 0
#endif

#define LAS __attribute__((address_space(3)))
#define GAS __attribute__((address_space(1)))
typedef unsigned short bf16;
typedef short bf16x8 __attribute__((ext_vector_type(8)));
typedef float f32x4 __attribute__((ext_vector_type(4)));
typedef float f32x2 __attribute__((ext_vector_type(2)));
typedef unsigned u32x4 __attribute__((ext_vector_type(4)));
typedef unsigned u32x2 __attribute__((ext_vector_type(2)));

constexpr int DM = 1024, BATCH = 8, SEQ = 4096, DEPTH = 2, DFF = 2816, DIN = 7168, NPROJ = 3072, NGATE = 4096;
constexpr int MT = BATCH * SEQ;
constexpr int MH = MT;
constexpr int BH = BATCH;
constexpr int NSEG = 32, SEGL = 128;
constexpr int NGU = 2 * DFF;
constexpr float EPS = 1e-6f;

constexpr size_t MiB = 1u << 20;
constexpr size_t WS_CTL = 0, CTL_ZERO_BYTES = 32 * 1024;
constexpr size_t E_WGU = (size_t)NGU * DM, E_WD = (size_t)DM * DFF, E_WIN = (size_t)DIN * DM, E_WB = (size_t)4 * DM * 256, E_WOUT = (size_t)DM * DM;
constexpr size_t O_WGU1 = 0, O_WD1 = O_WGU1 + E_WGU, O_WIN = O_WD1 + E_WD, O_WB = O_WIN + E_WIN, O_WOUT = O_WB + E_WB, O_WGU2 = O_WOUT + E_WOUT, O_WD2 = O_WGU2 + E_WGU;
constexpr size_t O_WLRU = O_WD2 + E_WD, E_WLRU = 2 * 4 * 64 * 64;
constexpr size_t E_LAYER = O_WLRU + E_WLRU;
constexpr size_t WS_W = 2 * MiB;
constexpr size_t WS_PB = 104 * MiB + 512 * 1024;
constexpr int PB_N = 8192, PB_HGN = 0, PB_RGW = 256, PB_RGB = 512, PB_QN = 768, PB_KN = 832, PB_SINK = 896, PB_CW = 1024, PB_CB = 2048, PB_BA = 2304, PB_BX = 2560, PB_SP = 2816, PB_LB = 3072, PB_GB = 4096;
constexpr size_t WS_HN = 105 * MiB;
constexpr size_t WS_U = 169 * MiB;
constexpr size_t WS_HID = WS_U;
constexpr size_t WS_PROJ = WS_U;
constexpr size_t WS_GATES = WS_U;
constexpr size_t WS_MERGED = WS_U + 128 * MiB;
constexpr size_t WS_SH = WS_U + 192 * MiB;
constexpr size_t WS_SR = WS_U + 208 * MiB;
constexpr size_t WS_Y = WS_U + 224 * MiB;
constexpr size_t WS_DH = WS_U + 288 * MiB;
constexpr size_t WS_HEND = WS_DH + 256 * 1024;
constexpr size_t WS_PEND = WS_HEND + 256 * 1024;
constexpr size_t WS_END = WS_U + 289 * MiB;
static_assert(WS_W + 2 * E_LAYER * 2 <= WS_PB && WS_PB + DEPTH * PB_N * 4 <= WS_HN && WS_HN + (size_t)MT * DM * 2 <= WS_U && WS_HID + (size_t)MT * DFF * 2 <= WS_END, "ws map");
static_assert(WS_PROJ + (size_t)MT * NPROJ * 2 <= WS_SH && WS_GATES + (size_t)MT * NGATE <= WS_MERGED && WS_MERGED + (size_t)MT * DM * 2 <= WS_SH, "mixer-stage overlays");
constexpr int CW_BAR = 4096;
static_assert((CW_BAR + 3456) * 4 <= (int)CTL_ZERO_BYTES, "barrier words inside the per-call memset");
constexpr size_t WS_SSQ = WS_END;
constexpr size_t WS_END2 = WS_SSQ + (size_t)3 * DEPTH * MT * 16 * 4;
constexpr int RING_BYTES = 131072;
constexpr int LDSCTL_OFF = 143360;
constexpr int LDS_BYTES = 147456;

__device__ __forceinline__ int lane_id() { int l; asm volatile("v_mbcnt_lo_u32_b32 %0, -1, 0\n\tv_mbcnt_hi_u32_b32 %0, -1, %0" : "=v"(l)); return l; }
__device__ __forceinline__ float bf2f(unsigned h) { return __uint_as_float(h << 16); }
__device__ __forceinline__ unsigned f2bf(float f) { unsigned u = __float_as_uint(f); return (u + 0x7fffu + ((u >> 16) & 1u)) >> 16; }
__device__ __forceinline__ unsigned pk2(float lo, float hi) { return f2bf(lo) | (f2bf(hi) << 16); }
__device__ __forceinline__ unsigned cvt_pk_bf16(float lo, float hi) { unsigned r; asm volatile("v_cvt_pk_bf16_f32 %0, %1, %2" : "=v"(r) : "v"(lo), "v"(hi)); return r; }
__device__ __forceinline__ float sigmoidf_(float x) { return __builtin_amdgcn_rcpf(1.0f + __expf(-x)); }
template <int O> __device__ __forceinline__ float swz_xor(float v) { return __int_as_float(__builtin_amdgcn_ds_swizzle(__float_as_int(v), (O << 10) | 0x1f)); }
__device__ __forceinline__ float wave_sum(float v, int lane) {
    v += swz_xor<1>(v); v += swz_xor<2>(v); v += swz_xor<4>(v); v += swz_xor<8>(v); v += swz_xor<16>(v);
    v += __int_as_float(__builtin_amdgcn_ds_bpermute((lane ^ 32) << 2, __float_as_int(v)));
    return v;
}
__device__ __forceinline__ void unpack8(const u32x4 v, float* o) {
    o[0] = __uint_as_float(v.x << 16); o[1] = __uint_as_float(v.x & 0xffff0000u);
    o[2] = __uint_as_float(v.y << 16); o[3] = __uint_as_float(v.y & 0xffff0000u);
    o[4] = __uint_as_float(v.z << 16); o[5] = __uint_as_float(v.z & 0xffff0000u);
    o[6] = __uint_as_float(v.w << 16); o[7] = __uint_as_float(v.w & 0xffff0000u);
}

struct RsRaw { f32x4 a, b, c, d; };
__device__ __forceinline__ RsRaw rs_load(const float* part) { RsRaw r; r.a = *(const f32x4*)part; r.b = *(const f32x4*)(part + 4); r.c = *(const f32x4*)(part + 8); r.d = *(const f32x4*)(part + 12); return r; }
__device__ __forceinline__ float rs_finish(const RsRaw& r) {
    const float s = (((r.a[0] + r.a[1]) + (r.a[2] + r.a[3])) + ((r.b[0] + r.b[1]) + (r.b[2] + r.b[3]))) + (((r.c[0] + r.c[1]) + (r.c[2] + r.c[3])) + ((r.d[0] + r.d[1]) + (r.d[2] + r.d[3])));
    return 1.0f / sqrtf(s * (1.f / DM) + EPS);
}
namespace pg8 {
constexpr int BM = 256, BK = 64, HALF = 128, HTB = HALF * BK * 2, STAGE_BYTES = 8 * HTB, NXCD = 8, WGM = 8;
__host__ __device__ __forceinline__ int lds_byte(int r, int c) { const int st = (r >> 4) * 2 + (c >> 5), rr = r & 15, cc = c & 31, ob = rr * 64 + cc * 2; return st * 1024 + (ob ^ (((ob >> 9) & 1) << 5)); }
__host__ __device__ __forceinline__ void stage_rc(int b, int& R, int& C) { const int st = b / 1024, sb = b % 1024, swz = sb ^ (((sb >> 9) & 1) << 5); R = (st >> 1) * 16 + swz / 64; C = (st & 1) * 32 + (swz % 64) / 2; }
__host__ __device__ __forceinline__ int perm32(int rho) { const int n = rho >> 4, i = rho & 15; return 8 * (i >> 2) + 4 * n + (i & 3); }

struct Unit { int pm, pn, aux; const char* a; const char* b; };
struct Gemm { int lda, ldb, K; };

struct StaticOrder {
    int nM, nN, nwg, G, c; const char* A; const char* Bt; size_t ta, tb;
    __device__ void init(int M, int N, int G_, int c_, const void* A_, int lda, const void* Bt_, int ldb) {
        nM = M / BM; nN = N / BM; nwg = nM * nN; G = G_; c = c_; A = (const char*)A_; Bt = (const char*)Bt_; ta = (size_t)BM * lda * 2; tb = (size_t)BM * ldb * 2; }
    __device__ bool next(int i, Unit& u) const {
        const long L = (long)i * G + c; if (L >= nwg) return false;
        int wgid = (int)L; { const int q = nwg / NXCD, r = nwg % NXCD, xcd = wgid % NXCD, off = wgid / NXCD; wgid = (xcd < r ? xcd * (q + 1) : r * (q + 1) + (xcd - r) * q) + off; }
        const int nig = WGM * nN, gid = wgid / nig, fm = gid * WGM, gsz = (nM - fm) < WGM ? (nM - fm) : WGM;
        u.pm = fm + ((wgid % nig) % gsz); u.pn = (wgid % nig) / gsz; u.aux = 0; u.a = A + (size_t)u.pm * ta; u.b = Bt + (size_t)u.pn * tb; return true;
    }
};
struct MergeOrder {
    int nM, nN, nwg, G, c; const char* Y; const char* Wb;
    __device__ void init(int M, int G_, int c_, const void* Y_, const void* Wb_) { nM = M / BM; nN = DM / HALF; nwg = nM * nN; G = G_; c = c_; Y = (const char*)Y_; Wb = (const char*)Wb_; }
    __device__ bool next(int i, Unit& u) const {
        const long L = (long)i * G + c; if (L >= nwg) return false;
        int wgid = (int)L; { const int q = nwg / NXCD, r = nwg % NXCD, xcd = wgid % NXCD, off = wgid / NXCD; wgid = (xcd < r ? xcd * (q + 1) : r * (q + 1) + (xcd - r) * q) + off; }
        const int nig = WGM * nN, gid = wgid / nig, fm = gid * WGM, gsz = (nM - fm) < WGM ? (nM - fm) : WGM;
        u.pm = fm + ((wgid % nig) % gsz); u.pn = (wgid % nig) / gsz; u.aux = 0;
        u.a = Y + (size_t)u.pm * BM * DM * 2; u.b = Wb + (size_t)u.pn * HALF * DM * 2; return true;
    }
};

struct EpiSwiglu {
    static constexpr bool PERM = true;
    static constexpr bool NEEDS_RS = true;
    unsigned char* ws; unsigned ssq_off;
    __device__ __forceinline__ const float* rs_ptr(int row) const { return (const float*)(ws + WS_SSQ) + ((size_t)ssq_off + row) * 16; }
    __device__ __forceinline__ void operator()(const f32x4 (&acc)[2][2][4][2], const Unit& u, int wr, int wc, int fr, int fq, const LAS float* rsl) const {
        const int row0 = u.pm * BM + wr * 64 + fr, col0 = u.pn * HALF + wc * 32 + 8 * fq;
        bf16* O = (bf16*)(ws + WS_HID);
#pragma unroll
        for (int ai = 0; ai < 2; ++ai)
#pragma unroll
            for (int m = 0; m < 4; ++m) {
                const int row = row0 + ai * HALF + m * 16;
                const float rs = rsl[ai * HALF + wr * 64 + m * 16 + fr];
                float o[8];
#pragma unroll
                for (int n = 0; n < 2; ++n)
#pragma unroll
                    for (int e = 0; e < 4; ++e) { const float g = acc[ai][0][m][n][e] * rs, up = acc[ai][1][m][n][e] * rs; o[n * 4 + e] = g * up * __builtin_amdgcn_rcpf(1.0f + __expf(-g)); }
                u32x4 w; w.x = cvt_pk_bf16(o[0], o[1]); w.y = cvt_pk_bf16(o[2], o[3]); w.z = cvt_pk_bf16(o[4], o[5]); w.w = cvt_pk_bf16(o[6], o[7]);
                __builtin_nontemporal_store(w, (u32x4*)(O + (size_t)row * DFF + col0)); }
    }
};
struct EpiResid {
    static constexpr bool PERM = true;
    static constexpr bool NEEDS_RS = false;
    float* out; float scale; unsigned char* ws; unsigned x_off, ssq_off; bool feed, fin;
    __device__ __forceinline__ const float* rs_ptr(int) const { return nullptr; }
    __device__ __forceinline__ void operator()(const f32x4 (&acc)[2][2][4][2], const Unit& u, int wr, int wc, int fr, int fq, const LAS float*) const {
        const int row0 = u.pm * BM + wr * 64 + fr, col0 = u.pn * BM + wc * 32 + 8 * fq;
        const int lane = fq * 16 + fr;
        bf16* xb = (bf16*)(ws + WS_HN) + x_off; float* ssq = (float*)(ws + WS_SSQ) + (size_t)ssq_off * 16;
#pragma unroll
        for (int ai = 0; ai < 2; ++ai)
#pragma unroll
            for (int m = 0; m < 4; ++m) { const size_t off = (size_t)(row0 + ai * HALF + m * 16) * DM + col0; float q = 0.f;
#pragma unroll
                for (int bj = 0; bj < 2; ++bj) {
                    float x[8]; unpack8(*(const u32x4*)(xb + off + bj * HALF), x);
#pragma unroll
                    for (int e = 0; e < 4; ++e) { x[e] += acc[ai][bj][m][0][e] * scale; x[4 + e] += acc[ai][bj][m][1][e] * scale; }
                    if (fin) { *(f32x4*)(out + x_off + off + bj * HALF) = (f32x4){x[0], x[1], x[2], x[3]}; *(f32x4*)(out + x_off + off + bj * HALF + 4) = (f32x4){x[4], x[5], x[6], x[7]}; }
                    else { u32x4 w; w.x = cvt_pk_bf16(x[0], x[1]); w.y = cvt_pk_bf16(x[2], x[3]); w.z = cvt_pk_bf16(x[4], x[5]); w.w = cvt_pk_bf16(x[6], x[7]); *(u32x4*)(xb + off + bj * HALF) = w;
                        if (feed) { float r[8]; unpack8(w, r);
#pragma unroll
                            for (int e = 0; e < 8; ++e) q += r[e] * r[e]; } } }
                if (feed) { q += swz_xor<16>(q); q += __int_as_float(__builtin_amdgcn_ds_bpermute((lane ^ 32) << 2, __float_as_int(q)));
                    if (fq == 0) ssq[(size_t)(row0 + ai * HALF + m * 16) * 16 + u.pn * 4 + wc] = q; } }
    }
};
struct EpiWin {
    static constexpr bool PERM = true;
    static constexpr bool NEEDS_RS = true;
    unsigned char* ws; unsigned pb_off, ssq_off; bool gphase;
    __device__ __forceinline__ const float* rs_ptr(int row) const { return (const float*)(ws + WS_SSQ) + ((size_t)ssq_off + row) * 16; }
    __device__ __forceinline__ void operator()(const f32x4 (&acc)[2][2][4][2], const Unit& u, int wr, int wc, int fr, int fq, const LAS float* rsl) const {
        const int row0 = u.pm * BM + wr * 64 + fr;
        bf16* proj = (bf16*)(ws + WS_PROJ); bf16* gates = (bf16*)(ws + WS_GATES); const float* gbias = (const float*)(ws + WS_PB) + pb_off;
        const bool isg = gphase;
        const int colt = u.pn * BM + wc * 32 + 8 * fq;
        f32x4 bv[2][2];
#pragma unroll
        for (int bj = 0; bj < 2; ++bj)
#pragma unroll
            for (int n = 0; n < 2; ++n) bv[bj][n] = isg ? *(const f32x4*)(gbias + colt + bj * HALF + 4 * n) : (f32x4){0.f, 0.f, 0.f, 0.f};
#pragma unroll
        for (int ai = 0; ai < 2; ++ai)
#pragma unroll
            for (int m = 0; m < 4; ++m) { const int rr = row0 + ai * HALF + m * 16;
                const float rs = rsl[ai * HALF + wr * 64 + m * 16 + fr];
#pragma unroll
                for (int bj = 0; bj < 2; ++bj) { f32x4 v0 = acc[ai][bj][m][0] * rs + bv[bj][0], v1 = acc[ai][bj][m][1] * rs + bv[bj][1];
                    if (isg) {
#pragma unroll
                        for (int e = 0; e < 4; ++e) { v0[e] = __builtin_amdgcn_rcpf(1.0f + __expf(-v0[e])); v1[e] = __builtin_amdgcn_rcpf(1.0f + __expf(-v1[e])); } }
                    const size_t eidx = ((size_t)((colt + bj * HALF) >> 6) * MH + rr) * 64 + ((colt + bj * HALF) & 63);
                    if (isg) {
                        u32x2 w = {0u, 0u};
                        w.x = __builtin_amdgcn_cvt_pk_u8_f32(v0[0] * 255.0f, 0, w.x); w.x = __builtin_amdgcn_cvt_pk_u8_f32(v0[1] * 255.0f, 1, w.x); w.x = __builtin_amdgcn_cvt_pk_u8_f32(v0[2] * 255.0f, 2, w.x); w.x = __builtin_amdgcn_cvt_pk_u8_f32(v0[3] * 255.0f, 3, w.x);
                        w.y = __builtin_amdgcn_cvt_pk_u8_f32(v1[0] * 255.0f, 0, w.y); w.y = __builtin_amdgcn_cvt_pk_u8_f32(v1[1] * 255.0f, 1, w.y); w.y = __builtin_amdgcn_cvt_pk_u8_f32(v1[2] * 255.0f, 2, w.y); w.y = __builtin_amdgcn_cvt_pk_u8_f32(v1[3] * 255.0f, 3, w.y);
                        __builtin_nontemporal_store(w, (u32x2*)((unsigned char*)gates + eidx));
                    } else {
                        u32x4 w; w.x = cvt_pk_bf16(v0[0], v0[1]); w.y = cvt_pk_bf16(v0[2], v0[3]); w.z = cvt_pk_bf16(v1[0], v1[1]); w.w = cvt_pk_bf16(v1[2], v1[3]);
                        __builtin_nontemporal_store(w, (u32x4*)(proj + eidx)); } } }
    }
};
struct EpiMerge {
    static constexpr bool PERM = true;
    static constexpr bool NEEDS_RS = false;
    unsigned char* ws;
    __device__ __forceinline__ const float* rs_ptr(int) const { return nullptr; }
    __device__ __forceinline__ void gate_load(u32x2 (&gv)[2][4], const Unit& u, int nb, int wr, int wc, int fr, int fq) const {
        const int row0 = u.pm * BM + wr * 64 + fr, col0 = u.pn * HALF + wc * 32 + 8 * fq;
        const unsigned char* gates = (const unsigned char*)(ws + WS_GATES);
#pragma unroll
        for (int ai = 0; ai < 2; ++ai)
#pragma unroll
            for (int m = 0; m < 4; ++m) gv[ai][m] = *(const u32x2*)(gates + (((size_t)((nb * DM + col0) >> 6) * MH + (row0 + ai * HALF + m * 16)) * 64 + ((nb * DM + col0) & 63)));
    }
    __device__ __forceinline__ void hook(f32x4 (&acc)[2][2][4][2], const u32x2 (&gv)[2][4]) const {
#pragma unroll
        for (int ai = 0; ai < 2; ++ai)
#pragma unroll
            for (int m = 0; m < 4; ++m) {
#pragma unroll
                for (int e = 0; e < 4; ++e) { acc[ai][1][m][0][e] += (float)((gv[ai][m].x >> (8 * e)) & 0xffu) * acc[ai][0][m][0][e]; acc[ai][1][m][1][e] += (float)((gv[ai][m].y >> (8 * e)) & 0xffu) * acc[ai][0][m][1][e]; }
                acc[ai][0][m][0] = (f32x4){0.f, 0.f, 0.f, 0.f}; acc[ai][0][m][1] = (f32x4){0.f, 0.f, 0.f, 0.f}; }
    }
    __device__ __forceinline__ void operator()(const f32x4 (&acc)[2][2][4][2], const Unit& u, int wr, int wc, int fr, int fq, const LAS float*) const {
        const int row0 = u.pm * BM + wr * 64 + fr, col0 = u.pn * HALF + wc * 32 + 8 * fq;
        bf16* merged = (bf16*)(ws + WS_MERGED);
#pragma unroll
        for (int ai = 0; ai < 2; ++ai)
#pragma unroll
            for (int m = 0; m < 4; ++m) { const f32x4 v0 = acc[ai][1][m][0] * (1.0f / 255.0f), v1 = acc[ai][1][m][1] * (1.0f / 255.0f);
                u32x4 w; w.x = cvt_pk_bf16(v0[0], v0[1]); w.y = cvt_pk_bf16(v0[2], v0[3]); w.z = cvt_pk_bf16(v1[0], v1[1]); w.w = cvt_pk_bf16(v1[2], v1[3]);
                *(u32x4*)(merged + (size_t)(row0 + ai * HALF + m * 16) * DM + col0) = w; }
    }
};

template <class Epi, class Sched, bool ALIGN_EPI, bool HALFN = false>
__device__ __forceinline__ void gemm_phase(LAS unsigned char* lds, const int tid, const Gemm g, const Sched& S, const Epi& E) {
    const int wid = __builtin_amdgcn_readfirstlane(tid >> 6), lane = tid & 63, wr = wid >> 2, wc = wid & 3, fr = lane & 15, fq = lane >> 4;
    int K = g.K; asm volatile("" : "+s"(K));
    const int nt = K / BK;
    unsigned voffA[2], voffB[2];
#pragma unroll
    for (int i = 0; i < 2; ++i) { int R, C; stage_rc(tid * 16 + i * 8192, R, C); const int Rb = Epi::PERM ? ((R & ~31) + perm32(R & 31)) : R;
        voffA[i] = (unsigned)(R * g.lda + C) * 2u; voffB[i] = (unsigned)(Rb * g.ldb + C) * 2u; }
    const size_t kstep = (size_t)(BK * 2);
    const size_t hstepA = (size_t)HALF * g.lda * 2, hstepB = (size_t)HALF * g.ldb * 2;
    const unsigned ldsw = (unsigned)wid * 1024u;
    const int aoff = lds_byte(wr * 64 + fr, fq * 8), boff = lds_byte(wc * 32 + fr, fq * 8);
#define PG8_SA(b, h) (((b) * 2 + (h)) * HTB)
#define PG8_SB(b, h) ((4 + (b) * 2 + (h)) * HTB)
#define PG8_STAGE(bufoff, gbase, voff) do { _Pragma("unroll") for (int _i = 0; _i < 2; ++_i) \
        __builtin_amdgcn_global_load_lds((const unsigned*)((const char*)(gbase) + (voff)[_i]), (LAS unsigned*)(lds + (bufoff) + ldsw + _i * 8192), 16, 0, 0); } while (0)
#define PG8_LDA(dst, b, h) do { _Pragma("unroll") for (int m = 0; m < 4; ++m) _Pragma("unroll") for (int k = 0; k < 2; ++k) dst[m][k] = *(const LAS bf16x8*)(lds + PG8_SA(b, h) + aoff + m * 2048 + k * 1024); } while (0)
#define PG8_LDB(dst, b, h) do { _Pragma("unroll") for (int n = 0; n < 2; ++n) _Pragma("unroll") for (int k = 0; k < 2; ++k) dst[n][k] = *(const LAS bf16x8*)(lds + PG8_SB(b, h) + boff + n * 2048 + k * 1024); } while (0)
#define PG8_MMA(ai, bj, At, Bt) do { __builtin_amdgcn_s_setprio(1); _Pragma("unroll") for (int m = 0; m < 4; ++m) _Pragma("unroll") for (int n = 0; n < 2; ++n) _Pragma("unroll") for (int k = 0; k < 2; ++k) \
        acc[ai][bj][m][n] = __builtin_amdgcn_mfma_f32_16x16x32_bf16(Bt[n][k], At[m][k], acc[ai][bj][m][n], 0, 0, 0); __builtin_amdgcn_s_setprio(0); } while (0)
#define PG8_WAIT_V(n) asm volatile("s_waitcnt vmcnt(" #n ")" ::: "memory")
#define PG8_WAIT_L(n) asm volatile("s_waitcnt lgkmcnt(" #n ")" ::: "memory")
#define PG8_BAR __builtin_amdgcn_s_barrier()
#define PG8_SCHED __builtin_amdgcn_sched_barrier(0)
    Unit cur, nxt; int ui = 0;
    if (!S.next(0, cur)) return;
    LAS float* RS = (LAS float*)(lds + STAGE_BYTES);
    if constexpr (Epi::NEEDS_RS) { if (tid < 256) RS[tid] = rs_finish(rs_load(E.rs_ptr(cur.pm * BM + tid))); }
    u32x2 gv[2][4];
    if constexpr (HALFN) E.gate_load(gv, cur, 0, wr, wc, fr, fq);
    f32x4 acc[2][2][4][2];
#pragma unroll
    for (int a = 0; a < 2; ++a)
#pragma unroll
        for (int b = 0; b < 2; ++b)
#pragma unroll
            for (int m = 0; m < 4; ++m)
#pragma unroll
                for (int n = 0; n < 2; ++n) acc[a][b][m][n] = (f32x4){0.f, 0.f, 0.f, 0.f};
    bf16x8 At[4][2], B0[2][2], B1[2][2];
    const char* cA = cur.a; const char* cB = cur.b;
    PG8_STAGE(PG8_SB(0, 0), cB, voffB); PG8_STAGE(PG8_SB(0, 1), cB + hstepB, voffB); PG8_STAGE(PG8_SA(0, 0), cA, voffA); PG8_STAGE(PG8_SA(0, 1), cA + hstepA, voffA);
    if (wr == 1) PG8_BAR;
    PG8_WAIT_V(2); PG8_BAR;
    PG8_STAGE(PG8_SB(1, 0), cB + kstep, voffB); PG8_STAGE(PG8_SA(1, 0), cA + kstep, voffA); PG8_STAGE(PG8_SB(1, 1), cB + hstepB + kstep, voffB);
    PG8_WAIT_V(6); PG8_BAR;
    for (;;) {
        const bool has_next = S.next(ui + 1, nxt);
        const char* nA = has_next ? nxt.a : cA; const char* nB = has_next ? nxt.b : cB;
        for (int t = 0; t < nt; t += 2) {
            const bool last = (t == nt - 2);
            const char* a1 = cA + (size_t)(t + 1) * kstep;
            const char* a2 = last ? nA : cA + (size_t)(t + 2) * kstep; const char* b2 = last ? nB : cB + (size_t)(t + 2) * kstep;
            const char* a3 = a2 + kstep; const char* b3 = b2 + kstep;
            PG8_LDB(B0, 0, 0); if constexpr (!HALFN) PG8_LDB(B1, 0, 1); PG8_SCHED; PG8_LDA(At, 0, 0); PG8_STAGE(PG8_SA(1, 1), a1 + hstepA, voffA);
            PG8_WAIT_V(8); PG8_WAIT_L(0); PG8_BAR; PG8_MMA(0, 0, At, B0); if constexpr (!HALFN) PG8_MMA(0, 1, At, B1); PG8_BAR; PG8_SCHED;
            PG8_LDA(At, 0, 1); PG8_STAGE(PG8_SB(0, 0), b2, voffB); PG8_STAGE(PG8_SB(0, 1), b2 + hstepB, voffB); PG8_STAGE(PG8_SA(0, 0), a2, voffA);
            PG8_WAIT_V(8); PG8_WAIT_L(0); PG8_BAR; PG8_MMA(1, 0, At, B0); if constexpr (!HALFN) PG8_MMA(1, 1, At, B1); PG8_BAR; PG8_SCHED;
            PG8_LDB(B0, 1, 0); if constexpr (!HALFN) PG8_LDB(B1, 1, 1); PG8_SCHED; PG8_LDA(At, 1, 0); PG8_STAGE(PG8_SA(0, 1), a2 + hstepA, voffA);
            PG8_WAIT_V(8); PG8_WAIT_L(0); PG8_BAR; PG8_MMA(0, 0, At, B0); if constexpr (!HALFN) PG8_MMA(0, 1, At, B1); PG8_BAR; PG8_SCHED;
            PG8_LDA(At, 1, 1); PG8_STAGE(PG8_SB(1, 0), b3, voffB); PG8_STAGE(PG8_SB(1, 1), b3 + hstepB, voffB); PG8_STAGE(PG8_SA(1, 0), a3, voffA);
            PG8_WAIT_V(8); PG8_WAIT_L(0); PG8_BAR; PG8_MMA(1, 0, At, B0); if constexpr (!HALFN) PG8_MMA(1, 1, At, B1); PG8_BAR; PG8_SCHED;
            if constexpr (HALFN) { if ((t & 3) == 2) {
                E.hook(acc, gv);
                const int el = lane_id(); int ewr = wr, ewc = wc; asm volatile("" : "+s"(ewr), "+s"(ewc));
                if (!last) E.gate_load(gv, cur, (t >> 2) + 1, ewr, ewc, el & 15, el >> 4);
                else if (has_next) E.gate_load(gv, nxt, 0, ewr, ewc, el & 15, el >> 4); } }
        }
        if constexpr (ALIGN_EPI) { if (wr == 0) PG8_BAR; }
        { const int el = lane_id(); const int efr = el & 15, efq = el >> 4; int ewr = wr, ewc = wc; asm volatile("" : "+s"(ewr), "+s"(ewc));
          RsRaw nraw; nraw.a = nraw.b = nraw.c = nraw.d = (f32x4){0.f, 0.f, 0.f, 0.f};
          if constexpr (Epi::NEEDS_RS) { if (has_next && ewr == 0) nraw = rs_load(E.rs_ptr(nxt.pm * BM + ewc * 64 + el)); }
          E(acc, cur, ewr, ewc, efr, efq, RS + (ui & 1) * 256);
          if constexpr (Epi::NEEDS_RS) { if (has_next && ewr == 0) RS[((ui + 1) & 1) * 256 + ewc * 64 + el] = rs_finish(nraw); } }
        if (!has_next) break;
#pragma unroll
        for (int a = 0; a < 2; ++a)
#pragma unroll
            for (int b = 0; b < 2; ++b)
#pragma unroll
                for (int m = 0; m < 4; ++m)
#pragma unroll
                    for (int n = 0; n < 2; ++n) acc[a][b][m][n] = (f32x4){0.f, 0.f, 0.f, 0.f};
        cur = nxt; cA = nA; cB = nB; ++ui;
        if constexpr (ALIGN_EPI) { if (wr == 1) PG8_BAR; }
    }
    PG8_WAIT_V(0);
    if constexpr (!ALIGN_EPI) { if (wr == 0) PG8_BAR; }
    PG8_BAR;
#undef PG8_SA
#undef PG8_SB
#undef PG8_STAGE
#undef PG8_LDA
#undef PG8_LDB
#undef PG8_MMA
#undef PG8_WAIT_V
#undef PG8_WAIT_L
#undef PG8_BAR
#undef PG8_SCHED
}
}

#define XB_TMO      128
#define XB_XCNT(j)  (256  + 64 * (j))
#define XB_XSUB(j)  (1280 + 64 * (j))
#define XB_XGEN(j)  (2304 + 64 * (j))
#define XB_TOP      3328
#define XB_TOPGEN   3392
#define XCD_BAR_WORDS 3456
#define XB_SPIN_CAP (1u << 18)
__device__ __forceinline__ unsigned xb_ld(unsigned* p)              { return __hip_atomic_load(p, __ATOMIC_RELAXED, __HIP_MEMORY_SCOPE_AGENT); }
__device__ __forceinline__ unsigned xb_add(unsigned* p, unsigned v) { return __hip_atomic_fetch_add(p, v, __ATOMIC_RELAXED, __HIP_MEMORY_SCOPE_AGENT); }
__device__ __forceinline__ unsigned xb_xcc_id() { return (unsigned)__builtin_amdgcn_s_getreg((3 << 11) | 20) & 0xFu; }
#define XB_SPIN(cond, bar) do { unsigned _sp = 0; while (cond) { __builtin_amdgcn_s_sleep(1); \
    if ((++_sp & 255u) == 0u) { if (xb_ld(&(bar)[XB_TMO])) break; if (_sp > XB_SPIN_CAP) { atomicAdd(&(bar)[XB_TMO], 1u); break; } } } } while (0)
struct XcdBarrier { unsigned* bar; unsigned x; volatile LAS unsigned* st; int wave; };
__device__ __forceinline__ XcdBarrier xcd_barrier_post(unsigned* bar, volatile LAS unsigned* st, int wave) {
    XcdBarrier b; b.bar = bar; b.x = xb_xcc_id(); b.st = st; b.wave = wave;
    if (wave == 0 && lane_id() == 0) (void)xb_add(&bar[XB_XCNT(b.x)], 1u);
    return b;
}
__device__ __forceinline__ void xcd_barrier_complete(unsigned* bar, unsigned x, unsigned& nloc, unsigned& nx) {
    const unsigned G = gridDim.x * gridDim.y * gridDim.z;
    unsigned sum, cnt, mine, sp = 0u;
    for (;;) {
        sum = 0u; cnt = 0u; mine = 0u;
#pragma unroll
        for (unsigned j = 0; j < 16; ++j) { const unsigned c = xb_ld(&bar[XB_XCNT(j)]); sum += c; cnt += (c > 0u) ? 1u : 0u; mine = (j == x) ? c : mine; }
        if (sum == G) break;
        __builtin_amdgcn_s_sleep(1);
        if ((++sp & 255u) == 0u) { if (xb_ld(&bar[XB_TMO])) break; if (sp > XB_SPIN_CAP) { atomicAdd(&bar[XB_TMO], 1u); break; } }
    }
    nloc = mine > 0u ? mine : 1u; nx = cnt > 0u ? cnt : 1u;
}
__device__ __forceinline__ void xcd_barrier(const XcdBarrier& b) {
    asm volatile("s_waitcnt vmcnt(0)" ::: "memory");
    __syncthreads();
    if (b.wave == 0 && lane_id() == 0) {
        unsigned* bar = b.bar;
        __builtin_amdgcn_s_waitcnt(0);
        unsigned nloc = b.st[0], nx = b.st[1];
        if (nloc == 0u) { xcd_barrier_complete(bar, b.x, nloc, nx); b.st[0] = nloc; b.st[1] = nx; }
        const unsigned old = xb_add(&bar[XB_XSUB(b.x)], 1u);
        const unsigned gen = old / nloc;
        if (old + 1u == (gen + 1u) * nloc) {
            __builtin_amdgcn_fence(__ATOMIC_RELEASE, "agent");
            asm volatile("s_waitcnt vmcnt(0)" ::: "memory");
            const unsigned og = xb_add(&bar[XB_TOP], 1u);
            const unsigned tg = og / nx;
            if (og + 1u == (tg + 1u) * nx) xb_add(&bar[XB_TOPGEN], 1u);
            else XB_SPIN(xb_ld(&bar[XB_TOPGEN]) == tg, bar);
            __builtin_amdgcn_fence(__ATOMIC_ACQUIRE, "agent");
            xb_add(&bar[XB_XGEN(b.x)], 1u);
            asm volatile("s_waitcnt vmcnt(0)" ::: "memory");
        } else {
            XB_SPIN(xb_ld(&bar[XB_XGEN(b.x)]) == gen, bar);
            __builtin_amdgcn_fence(__ATOMIC_ACQUIRE, "agent");
            asm volatile("s_waitcnt vmcnt(0)" ::: "memory");
        }
    }
    __syncthreads();
}

struct Args { const float* in[28]; float* out; unsigned char* ws; int ph_lo, ph_hi; };
enum { I_X = 0, I_F1N, I_F1G, I_F1U, I_F1D, I_MIXN, I_WIN, I_GBIAS, I_LBL, I_HGN, I_RGW, I_RGB, I_QN, I_KN, I_SINK, I_CW, I_CB, I_WA, I_BA, I_WX, I_BX, I_LAM, I_WBR, I_WOUT, I_F2N, I_F2G, I_F2U, I_F2D };
typedef const float* CFP;
typedef const __attribute__((address_space(4))) CFP* InTab;
template <class T> __device__ __forceinline__ T* as_global(T* p) { return (T*)(GAS T*)p; }
struct InPtrs { InTab t; __device__ __forceinline__ const float* operator[](int i) const { return as_global(t[i]); } };
__host__ __device__ __forceinline__ size_t bm_idx(int row, int col) { return ((size_t)(col >> 6) * MH + row) * 64 + (col & 63); }
struct Ctx {
    LAS unsigned char* lds; int tid, lane, wave, G, bid;
    InPtrs in; float* out; unsigned char* ws;
    bf16 *W, *HN, *HID, *PROJ, *GATES, *MERGED; float *SH, *SR, *HLOC, *PCUM, *DH, *HEND, *PEND, *PB;
};
__device__ __forceinline__ Ctx phase_ctx(const Ctx& K) {
    Ctx C; C.lds = K.lds; C.G = K.G; C.bid = K.bid;
    int lane = lane_id(), wave = K.wave; InTab in = K.in.t; GAS float* outg = (GAS float*)K.out; GAS unsigned char* wsg = (GAS unsigned char*)K.ws;
    asm volatile("" : "+v"(lane)); asm volatile("" : "+s"(wave)); asm volatile("" : "+s"(in)); asm volatile("" : "+s"(outg)); asm volatile("" : "+s"(wsg));
    float* out = (float*)outg; unsigned char* ws = (unsigned char*)wsg;
    C.tid = wave * 64 + lane; C.lane = lane; C.wave = wave; C.in.t = in; C.out = out; C.ws = ws;
    C.W = (bf16*)(ws + WS_W); C.HN = (bf16*)(ws + WS_HN); C.HID = (bf16*)(ws + WS_HID); C.PROJ = (bf16*)(ws + WS_PROJ); C.GATES = (bf16*)(ws + WS_GATES); C.MERGED = (bf16*)(ws + WS_MERGED);
    C.SH = (float*)(ws + WS_SH); C.SR = (float*)(ws + WS_SR); C.HLOC = nullptr; C.PCUM = nullptr; C.DH = (float*)(ws + WS_DH); C.HEND = (float*)(ws + WS_HEND); C.PEND = (float*)(ws + WS_PEND); C.PB = (float*)(ws + WS_PB);
    return C;
}

struct ItemDesc { const float* src; bf16* dst; const float* gain; int ldw, ldt, k0, n0, orow; };
__device__ __forceinline__ void tr_load(const ItemDesc& d, float (&r)[32], int lane) {
#pragma unroll
    for (int i = 0; i < 32; ++i) r[i] = d.src[(size_t)(d.k0 + 2 * i + (lane >> 5)) * d.ldw + d.n0 + (lane & 31)];
}
__device__ __forceinline__ void tr_finish(const ItemDesc& d, const float (&r)[32], LAS float* scr, int lane) {
#pragma unroll
    for (int i = 0; i < 32; ++i) scr[(2 * i + (lane >> 5)) * 33 + (lane & 31)] = r[i];
    asm volatile("s_waitcnt lgkmcnt(0)" ::: "memory");
    const int c = lane & 7;
    f32x4 g0 = {1.f, 1.f, 1.f, 1.f}, g1 = g0;
    if (d.gain) { g0 = *(const f32x4*)(d.gain + d.k0 + 8 * c); g1 = *(const f32x4*)(d.gain + d.k0 + 8 * c + 4); }
#pragma unroll
    for (int j = 0; j < 4; ++j) { const int n = (lane >> 3) + 8 * j; const LAS float* s = scr + (8 * c) * 33 + n;
        u32x4 o; o.x = pk2(s[0 * 33] * g0[0], s[1 * 33] * g0[1]); o.y = pk2(s[2 * 33] * g0[2], s[3 * 33] * g0[3]); o.z = pk2(s[4 * 33] * g1[0], s[5 * 33] * g1[1]); o.w = pk2(s[6 * 33] * g1[2], s[7 * 33] * g1[3]);
        *(u32x4*)(d.dst + (size_t)(d.n0 + d.orow + n) * d.ldt + d.k0 + 8 * c) = o; }
    asm volatile("s_waitcnt lgkmcnt(0)" ::: "memory");
}
constexpr int IT_FF = 16 * 88, IT_FFN = 6 * IT_FF, IT_WIN = 16 * 224, IT_WB = 512, IT_WOUT = 512, IT_LAYER = IT_FFN + IT_WIN + IT_WB + IT_WOUT;
static_assert((DFF / 64) * (DM / 32) == IT_FF, "wd items == gate items");
__device__ __forceinline__ ItemDesc decode_item(const Ctx& C, int it) {
    ItemDesc d; d.gain = nullptr; d.orow = 0;
    const int l = it / IT_LAYER; int r = it % IT_LAYER;
    bf16* WL = C.W + (size_t)l * E_LAYER;
    if (r < IT_FFN) {
        const int s = r / IT_FF, q = r % IT_FF, f = s / 3, kind = s % 3;
        if (kind < 2) {
            const int kb = q / 88, nb = q % 88, n0 = 32 * nb;
            d.src = (f == 0 ? (kind == 0 ? C.in[I_F1G] : C.in[I_F1U]) : (kind == 0 ? C.in[I_F2G] : C.in[I_F2U])) + (size_t)l * DM * DFF;
            d.ldw = DFF; d.k0 = 64 * kb; d.n0 = n0; d.dst = WL + (f == 0 ? O_WGU1 : O_WGU2); d.ldt = DM; d.orow = 256 * (n0 / 128) + (n0 % 128) + 128 * kind - n0;
            d.gain = (f == 0 ? C.in[I_F1N] : C.in[I_F2N]) + l * DM;
        } else {
            const int kb = q / 32, nb = q % 32;
            d.src = (f == 0 ? C.in[I_F1D] : C.in[I_F2D]) + (size_t)l * DFF * DM; d.ldw = DM; d.k0 = 64 * kb; d.n0 = 32 * nb; d.dst = WL + (f == 0 ? O_WD1 : O_WD2); d.ldt = DFF;
        }
        return d;
    }
    r -= IT_FFN;
    if (r < IT_WIN) { const int kb = r / 224, nb = r % 224; d.src = C.in[I_WIN] + (size_t)l * DM * DIN; d.ldw = DIN; d.k0 = 64 * kb; d.n0 = 32 * nb; d.dst = WL + O_WIN; d.ldt = DM; d.gain = C.in[I_MIXN] + l * DM; return d; }
    r -= IT_WIN;
    if (r < IT_WB) { const int n = r / 128, q = r % 128, kb = q / 32, nb = q % 32; d.src = C.in[I_WBR] + (size_t)(l * 4 + n) * 256 * DM; d.ldw = DM; d.k0 = 64 * kb; d.n0 = 32 * nb; d.dst = WL + O_WB + (size_t)n * 256; d.ldt = DM; return d; }
    r -= IT_WB;
    { const int kb = r / 32, nb = r % 32; d.src = C.in[I_WOUT] + (size_t)l * DM * DM; d.ldw = DM; d.k0 = 64 * kb; d.n0 = 32 * nb; d.dst = WL + O_WOUT; d.ldt = DM; }
    return d;
}

__device__ __forceinline__ void norm_row(const float* xrow, const float* w, bf16* orow, int lane) {
    const f32x4* xr = (const f32x4*)xrow + lane; const f32x4* wr = (const f32x4*)w + lane;
    f32x4 v[4]; float s = 0.f;
#pragma unroll
    for (int j = 0; j < 4; ++j) { v[j] = xr[64 * j]; s += (v[j].x * v[j].x + v[j].y * v[j].y) + (v[j].z * v[j].z + v[j].w * v[j].w); }
    const float rstd = 1.0f / sqrtf(wave_sum(s, lane) * (1.f / DM) + EPS);
    unsigned long long* o8 = (unsigned long long*)orow + lane;
#pragma unroll
    for (int j = 0; j < 4; ++j) { const f32x4 g = wr[64 * j]; o8[64 * j] = (unsigned long long)pk2(v[j].x * rstd * g.x, v[j].y * rstd * g.y) | ((unsigned long long)pk2(v[j].z * rstd * g.z, v[j].w * rstd * g.w) << 32); }
}
__device__ __forceinline__ void norm_phase(const Ctx& C, const float* x, const float* w, bf16* out) {
    const int gw = C.bid * 8 + C.wave, NGW = C.G * 8;
    for (int m = gw; m < MT; m += NGW) norm_row(x + (size_t)m * DM, w, out + (size_t)m * DM, C.lane);
}

__device__ __forceinline__ float hgrn_lb(const float* logits, int l, int w) {
    if (l == 0) return 0.f;
    float mx = logits[w];
#pragma unroll
    for (int j = 1; j < DEPTH; ++j) mx = fmaxf(mx, logits[j * 256 + w]);
    float den = 0.f, num = 0.f;
#pragma unroll
    for (int j = 0; j < DEPTH; ++j) { const float e = __expf(logits[j * 256 + w] - mx); den += e; if (j >= 1 && j <= l) num += e; }
    return num / den;
}

__device__ __forceinline__ void lds_barrier() { asm volatile("s_waitcnt lgkmcnt(0)\n\ts_barrier" ::: "memory"); }
typedef short s16x4 __attribute__((ext_vector_type(4)));
typedef __bf16 bf16x2_t __attribute__((ext_vector_type(2)));
__device__ __forceinline__ unsigned pkbf(float a, float b) { const f32x2 f = {a, b}; return __builtin_bit_cast(unsigned, __builtin_convertvector(f, bf16x2_t)); }
__device__ __forceinline__ bf16x8 pack8(const f32x4 lo, const f32x4 hi) { u32x4 p; p.x = pkbf(lo[0], lo[1]); p.y = pkbf(lo[2], lo[3]); p.z = pkbf(hi[0], hi[1]); p.w = pkbf(hi[2], hi[3]); return __builtin_bit_cast(bf16x8, p); }
__device__ __forceinline__ f32x4 mfma16(const bf16x8 a, const bf16x8 b, const f32x4 c) { return __builtin_amdgcn_mfma_f32_16x16x32_bf16(a, b, c, 0, 0, 0); }
__device__ __forceinline__ bf16x8 ldsfrag(const LAS unsigned char* p) { return *(const LAS bf16x8*)p; }
constexpr int RS = 144;
__device__ __forceinline__ bf16x8 trfrag(const LAS unsigned char* img, int r0, int r1, int c0, int fr) {
    const int q = fr >> 2, p = fr & 3;
    const s16x4 lo = __builtin_amdgcn_ds_read_tr16_b64_v4i16((LAS s16x4*)(img + (r0 + q) * RS + (c0 + 4 * p) * 2));
    const s16x4 hi = __builtin_amdgcn_ds_read_tr16_b64_v4i16((LAS s16x4*)(img + (r1 + q) * RS + (c0 + 4 * p) * 2));
    return __builtin_shufflevector(lo, hi, 0, 1, 2, 3, 4, 5, 6, 7);
}
__device__ __forceinline__ float sum16(float v) { v += swz_xor<1>(v); v += swz_xor<2>(v); v += swz_xor<4>(v); v += swz_xor<8>(v); return v; }
__device__ __forceinline__ float xor32f(float v, int lane) { return __int_as_float(__builtin_amdgcn_ds_bpermute((lane ^ 32) << 2, __float_as_int(v))); }
__device__ __forceinline__ float sum4g(float v, int lane) { v += swz_xor<16>(v); v += xor32f(v, lane); return v; }
__device__ __forceinline__ float max4g(float v, int lane) { v = fmaxf(v, swz_xor<16>(v)); v = fmaxf(v, xor32f(v, lane)); return v; }

struct RetRegs { u32x4 rq[2], rk[2], rv[2], rg[2]; float s[8]; };
template <bool OUT>
__device__ __forceinline__ void ret_load(const Ctx& C, int bl, int seg, int h, RetRegs& R) {
    int tid = C.tid; asm volatile("" : "+v"(tid));
    const size_t rowbase = (size_t)(bl * SEQ + seg * SEGL);
    const float* Sg = C.SR + ((size_t)((bl * NSEG + seg) * 4 + h)) * 4096;
#pragma unroll
    for (int i = 0; i < 2; ++i) {
        const int idx = tid + 512 * i, row = idx >> 3, c8 = idx & 7, prow = (int)rowbase + row;
        if (OUT) { R.rq[i] = *(const u32x4*)(C.PROJ + bm_idx(prow, 1024 + h * 64 + 8 * c8)); R.rg[i] = *(const u32x4*)(C.PROJ + bm_idx(prow, 1792 + h * 64 + 8 * c8)); }
        R.rk[i] = *(const u32x4*)(C.PROJ + bm_idx(prow, 1280 + h * 64 + 8 * c8));
        R.rv[i] = *(const u32x4*)(C.PROJ + bm_idx(prow, 1536 + h * 64 + 8 * c8));
    }
    if (OUT) {
#pragma unroll
        for (int e = 0; e < 8; ++e) R.s[e] = Sg[(8 * (tid >> 6) + e) * 64 + (tid & 63)];
    }
}
template <bool OUT>
__device__ __forceinline__ void ret_unit_mfma(const Ctx& C, int l, int hb, int bl, int seg, int h, RetRegs& R, bool hn, int un) {
    LAS unsigned char* Qi = C.lds;
    LAS unsigned char* Ki = Qi + 128 * RS;
    LAS unsigned char* Vi = Ki + 128 * RS;
    LAS unsigned char* Si = Vi + 128 * RS;
    LAS unsigned char* Gi = Si + 64 * RS;
    const int tid = C.tid, lane = C.lane, w = C.wave, fr = lane & 15, fq = lane >> 4;
    const size_t rowbase = (size_t)(bl * SEQ + seg * SEGL);
    const float lg = __log2f(1.0f - exp2f(-5.0f - (float)h));
    float* Sg = C.SR + ((size_t)((bl * NSEG + seg) * 4 + h)) * 4096;
    u32x4 (&rq)[2] = R.rq; u32x4 (&rk)[2] = R.rk; u32x4 (&rv)[2] = R.rv; float (&s)[8] = R.s;
    lds_barrier();
#pragma unroll
    for (int i = 0; i < 2; ++i) {
        const int idx = tid + 512 * i, row = idx >> 3, c8 = idx & 7;
        if (OUT) *(LAS u32x4*)(Qi + row * RS + c8 * 16) = rq[i];
        u32x4 kv = rk[i];
        if (!OUT) { float f[8]; unpack8(kv, f); const float sc = exp2f((float)(127 - row) * lg); kv.x = pkbf(f[0] * sc, f[1] * sc); kv.y = pkbf(f[2] * sc, f[3] * sc); kv.z = pkbf(f[4] * sc, f[5] * sc); kv.w = pkbf(f[6] * sc, f[7] * sc); }
        *(LAS u32x4*)(Ki + row * RS + c8 * 16) = kv;
        *(LAS u32x4*)(Vi + row * RS + c8 * 16) = rv[i];
    }
    if (OUT) {
        const int v = tid & 63, kg = tid >> 6;
        u32x4 o; o.x = pkbf(s[0], s[1]); o.y = pkbf(s[2], s[3]); o.z = pkbf(s[4], s[5]); o.w = pkbf(s[6], s[7]);
        *(LAS u32x4*)(Si + v * RS + kg * 16) = o;
#pragma unroll
        for (int i = 0; i < 2; ++i) { const int idx = tid + 512 * i, row = idx >> 3, c8 = idx & 7; *(LAS u32x4*)(Gi + row * RS + c8 * 16) = R.rg[i]; }
    }
    if (hn) ret_load<OUT>(C, un >> 7, (un >> 2) & 31, un & 3, R);
    lds_barrier();
    const f32x4 z4 = {0.f, 0.f, 0.f, 0.f};
    if (!OUT) {
        const int kt = w >> 1, vt0 = (w & 1) * 2;
        f32x4 a0 = z4, a1 = z4;
#pragma unroll
        for (int jb = 0; jb < 4; ++jb) {
            const int j0 = 32 * jb + 8 * fq;
            const bf16x8 Af = trfrag(Ki, j0, j0 + 4, 16 * kt, fr);
            a0 = mfma16(Af, trfrag(Vi, j0, j0 + 4, 16 * vt0, fr), a0);
            a1 = mfma16(Af, trfrag(Vi, j0, j0 + 4, 16 * vt0 + 16, fr), a1);
        }
#pragma unroll
        for (int i = 0; i < 4; ++i) { Sg[(16 * kt + 4 * fq + i) * 64 + 16 * vt0 + fr] = a0[i]; Sg[(16 * kt + 4 * fq + i) * 64 + 16 * vt0 + 16 + fr] = a1[i]; }
        return;
    }
    const int t0 = 16 * w;
    float pgw[4], pgb[4];
#pragma unroll
    for (int vt = 0; vt < 4; ++vt) { pgw[vt] = C.PB[l * PB_N + PB_RGW + h * 64 + 16 * vt + fr]; pgb[vt] = C.PB[l * PB_N + PB_RGB + h * 64 + 16 * vt + fr]; }
    const bf16x8 Qf0 = ldsfrag(Qi + (t0 + fr) * RS + 16 * fq), Qf1 = ldsfrag(Qi + (t0 + fr) * RS + 16 * fq + 64);
    f32x4 O[4] = {z4, z4, z4, z4};
    for (int jb = 0; jb <= (w >> 1); ++jb) {
        f32x4 s0 = mfma16(ldsfrag(Ki + (32 * jb + fr) * RS + 16 * fq), Qf0, z4);
        s0 = mfma16(ldsfrag(Ki + (32 * jb + fr) * RS + 16 * fq + 64), Qf1, s0);
        f32x4 s1 = z4;
        if (2 * jb + 1 <= w) { s1 = mfma16(ldsfrag(Ki + (32 * jb + 16 + fr) * RS + 16 * fq), Qf0, z4); s1 = mfma16(ldsfrag(Ki + (32 * jb + 16 + fr) * RS + 16 * fq + 64), Qf1, s1); }
#pragma unroll
        for (int i = 0; i < 4; ++i) {
            const int d0 = (t0 + fr) - (32 * jb + 4 * fq + i), d1 = d0 - 16;
            s0[i] = d0 >= 0 ? s0[i] * exp2f((float)d0 * lg) : 0.f;
            s1[i] = d1 >= 0 ? s1[i] * exp2f((float)d1 * lg) : 0.f;
        }
        const bf16x8 Pf = pack8(s0, s1);
#pragma unroll
        for (int vt = 0; vt < 4; ++vt) O[vt] = mfma16(Pf, trfrag(Vi, 32 * jb + 4 * fq, 32 * jb + 16 + 4 * fq, 16 * vt, fr), O[vt]);
    }
#pragma unroll
    for (int vt = 0; vt < 4; ++vt) {
        f32x4 oi = mfma16(Qf0, ldsfrag(Si + (16 * vt + fr) * RS + 16 * fq), z4);
        oi = mfma16(Qf1, ldsfrag(Si + (16 * vt + fr) * RS + 16 * fq + 64), oi);
#pragma unroll
        for (int i = 0; i < 4; ++i) O[vt][i] = 0.125f * (O[vt][i] + exp2f((float)(t0 + 4 * fq + i + 1) * lg) * oi[i]);
    }
    bf16* Y = (bf16*)(C.ws + WS_Y);
#pragma unroll
    for (int i = 0; i < 4; ++i) {
        const float mu = sum16((O[0][i] + O[1][i]) + (O[2][i] + O[3][i])) * (1.f / 64.f);
        float q = 0.f;
#pragma unroll
        for (int vt = 0; vt < 4; ++vt) { const float d = O[vt][i] - mu; q += d * d; }
        const float rstd = 1.0f / sqrtf(sum16(q) * (1.f / 64.f) + EPS);
        const size_t row = rowbase + t0 + 4 * fq + i;
#pragma unroll
        for (int vt = 0; vt < 4; ++vt) {
            const int ch = h * 64 + 16 * vt + fr;
            const float g = bf2f(*(const LAS bf16*)(Gi + (t0 + 4 * fq + i) * RS + 2 * (16 * vt + fr)));
            const float y = ((O[vt][i] - mu) * rstd * pgw[vt] + pgb[vt]) * (g * sigmoidf_(g));
            *(LAS bf16*)(Qi + (t0 + 4 * fq + i) * RS + 2 * (16 * vt + fr)) = (bf16)f2bf(y);
            (void)row; (void)ch;
        }
    }
    asm volatile("s_waitcnt lgkmcnt(0)" ::: "memory");
#pragma unroll
    for (int i = 0; i < 2; ++i) { const int cidx = lane + 64 * i, rr = cidx >> 3, c8 = cidx & 7;
        *(u32x4*)(Y + (rowbase + t0 + rr) * DM + 256 + h * 64 + 8 * c8) = *(const LAS u32x4*)(Qi + (t0 + rr) * RS + c8 * 16); }
}

__device__ __forceinline__ void swa_unit_mfma(const Ctx& C, int l, int hb, int bl, int blk, int kvh) {
    LAS unsigned char* Ki = C.lds;
    LAS unsigned char* Vi = Ki + 256 * RS;
    const int tid = C.tid, lane = C.lane, w = C.wave, fr = lane & 15, fq = lane >> 4;
    u32x4 qraw[2][2];
#pragma unroll
    for (int tt = 0; tt < 2; ++tt) { const bf16* src = C.PROJ + bm_idx(bl * SEQ + blk * SEGL + 16 * ((w & 3) * 2 + tt) + fr, 2048 + (kvh * 2 + (w >> 2)) * 64 + 8 * fq);
        qraw[tt][0] = *(const u32x4*)src; qraw[tt][1] = *(const u32x4*)(src + 32); }
    u32x4 rk[4], rv[4];
#pragma unroll
    for (int i = 0; i < 4; ++i) {
        const int idx = tid + 512 * i, row = idx >> 3, c8 = idx & 7, pos = (blk - 1) * SEGL + row;
        const int pc = pos > 0 ? pos : 0;
        rk[i] = *(const u32x4*)(C.PROJ + bm_idx(bl * SEQ + pc, 2304 + kvh * 64 + 8 * c8)); rv[i] = *(const u32x4*)(C.PROJ + bm_idx(bl * SEQ + pc, 2432 + kvh * 64 + 8 * c8));
    }
    const f32x4 kw0 = *(const f32x4*)(C.PB + l * PB_N + PB_KN + 8 * (tid & 7)), kw1 = *(const f32x4*)(C.PB + l * PB_N + PB_KN + 8 * (tid & 7) + 4);
    const float* qn = C.PB + l * PB_N + PB_QN + 8 * fq;
    const f32x4 qw0 = *(const f32x4*)qn, qw1 = *(const f32x4*)(qn + 4), qw2 = *(const f32x4*)(qn + 32), qw3 = *(const f32x4*)(qn + 36);
    const float sink = C.PB[l * PB_N + PB_SINK + kvh * 2 + (w >> 2)];
    lds_barrier();
#pragma unroll
    for (int i = 0; i < 4; ++i) {
        const int idx = tid + 512 * i, row = idx >> 3, c8 = idx & 7;
        const bool zero = (blk - 1) * SEGL + row < 0;
        const u32x4 kv = zero ? (u32x4){0u, 0u, 0u, 0u} : rk[i], vv = zero ? (u32x4){0u, 0u, 0u, 0u} : rv[i];
        float f[8]; unpack8(kv, f);
        float ss = 0.f;
#pragma unroll
        for (int e = 0; e < 8; ++e) ss += f[e] * f[e];
        ss += swz_xor<1>(ss); ss += swz_xor<2>(ss); ss += swz_xor<4>(ss);
        const float r = 1.0f / sqrtf(ss * (1.f / 64.f) + EPS);
        const f32x4 w0 = kw0, w1 = kw1;
        u32x4 ko; ko.x = pkbf(f[0] * r * w0[0], f[1] * r * w0[1]); ko.y = pkbf(f[2] * r * w0[2], f[3] * r * w0[3]); ko.z = pkbf(f[4] * r * w1[0], f[5] * r * w1[1]); ko.w = pkbf(f[6] * r * w1[2], f[7] * r * w1[3]);
        *(LAS u32x4*)(Ki + row * RS + c8 * 16) = ko;
        *(LAS u32x4*)(Vi + row * RS + c8 * 16) = vv;
    }
    lds_barrier();
    const int g = w >> 2, h = kvh * 2 + g;
    const float slope = exp2f(-2.0f * (float)(h + 1));
    const f32x4 z4 = {0.f, 0.f, 0.f, 0.f};
    bf16* Y = (bf16*)(C.ws + WS_Y);
#pragma unroll 1
    for (int tt = 0; tt < 2; ++tt) {
        const int t0 = 16 * ((w & 3) * 2 + tt);
        const size_t qrow = (size_t)(bl * SEQ + blk * SEGL + t0);
        bf16x8 Qf0, Qf1;
        {
            float a[8], b[8]; unpack8(tt ? qraw[1][0] : qraw[0][0], a); unpack8(tt ? qraw[1][1] : qraw[0][1], b);
            float ss = 0.f;
#pragma unroll
            for (int e = 0; e < 8; ++e) ss += a[e] * a[e] + b[e] * b[e];
            ss = sum4g(ss, lane);
            const float r = 0.125f / sqrtf(ss * (1.f / 64.f) + EPS);
            const f32x4 w0 = qw0, w1 = qw1, w2 = qw2, w3 = qw3;
            u32x4 p; p.x = pkbf(a[0] * r * w0[0], a[1] * r * w0[1]); p.y = pkbf(a[2] * r * w0[2], a[3] * r * w0[3]); p.z = pkbf(a[4] * r * w1[0], a[5] * r * w1[1]); p.w = pkbf(a[6] * r * w1[2], a[7] * r * w1[3]);
            Qf0 = __builtin_bit_cast(bf16x8, p);
            p.x = pkbf(b[0] * r * w2[0], b[1] * r * w2[1]); p.y = pkbf(b[2] * r * w2[2], b[3] * r * w2[3]); p.z = pkbf(b[4] * r * w3[0], b[5] * r * w3[1]); p.w = pkbf(b[6] * r * w3[2], b[7] * r * w3[3]);
            Qf1 = __builtin_bit_cast(bf16x8, p);
        }
        const int jb0 = t0 >> 5;
        f32x4 s[10];
#pragma unroll
        for (int u = 0; u < 10; ++u) {
            const int jr = 32 * jb0 + 16 * u + fr;
            s[u] = mfma16(ldsfrag(Ki + jr * RS + 16 * fq), Qf0, z4);
            s[u] = mfma16(ldsfrag(Ki + jr * RS + 16 * fq + 64), Qf1, s[u]);
        }
        float m = sink;
        const unsigned dmax = blk > 0 ? 128u : (unsigned)(t0 + fr + 1);
#pragma unroll
        for (int u = 0; u < 10; ++u) {
#pragma unroll
            for (int i = 0; i < 4; ++i) {
                const int jl = 32 * jb0 + 16 * u + 4 * fq + i, dist = t0 + fr + 128 - jl;
                s[u][i] = (unsigned)dist < dmax ? s[u][i] - slope * (float)dist : -1e30f;
                m = fmaxf(m, s[u][i]);
            }
            __builtin_amdgcn_sched_barrier(0);
        }
        m = max4g(m, lane);
        float ls = 0.f;
#pragma unroll
        for (int u = 0; u < 10; ++u)
#pragma unroll
            for (int i = 0; i < 4; ++i) { const float p = __expf(s[u][i] - m); s[u][i] = p; ls += p; }
        ls = sum4g(ls, lane) + __expf(sink - m);
        const float inv = 1.0f / ls;
        f32x4 O[4] = {z4, z4, z4, z4};
#pragma unroll
        for (int jb = 0; jb < 5; ++jb) {
            const bf16x8 Pf = pack8(s[2 * jb] * inv, s[2 * jb + 1] * inv);
            const int j0 = 32 * (jb0 + jb) + 4 * fq;
#pragma unroll
            for (int vt = 0; vt < 4; ++vt) O[vt] = mfma16(Pf, trfrag(Vi, j0, j0 + 16, 16 * vt, fr), O[vt]);
        }
#pragma unroll
        for (int i = 0; i < 4; ++i)
#pragma unroll
            for (int vt = 0; vt < 4; ++vt) Y[(qrow + 4 * fq + i) * DM + 512 + h * 64 + 16 * vt + fr] = (bf16)f2bf(O[vt][i]);
    }
}

__device__ __forceinline__ float gelu_tanh(float x) { const float y = 0.7978845608028654f * (x + 0.044715f * x * x * x); const float t = 1.0f - 2.0f * __builtin_amdgcn_rcpf(1.0f + __expf(2.0f * y)); return 0.5f * x * (1.0f + t); }


struct HgRegs { u32x4 rq[2], rv[2]; float sv[8]; bf16 zr[16]; };
template <bool OUT>
__device__ __forceinline__ void hgrn_load(const Ctx& C, int bl, int seg, int h, HgRegs& R) {
    int tid = C.tid; asm volatile("" : "+v"(tid)); const int lane = tid & 63, w = C.wave; const size_t rowbase = (size_t)(bl * SEQ + seg * SEGL);
    const float* Sg = C.SH + ((size_t)((bl * NSEG + seg) * 4 + h)) * 4096;
#pragma unroll
    for (int i = 0; i < 2; ++i) {
        const int idx = tid + 512 * i, row = idx >> 3, c8 = idx & 7, prow = (int)rowbase + row;
        if (OUT) R.rq[i] = *(const u32x4*)(C.PROJ + bm_idx(prow, h * 64 + 8 * c8));
        R.rv[i] = *(const u32x4*)(C.PROJ + bm_idx(prow, 512 + h * 64 + 8 * c8));
    }
    if (OUT) {
#pragma unroll
        for (int e = 0; e < 8; ++e) R.sv[e] = Sg[(8 * (tid >> 6) + e) * 64 + (tid & 63)];
    }
    { const bf16* zs = C.PROJ + bm_idx((int)rowbase + 16 * w, 256 + h * 64 + lane);
#pragma unroll
      for (int t = 0; t < 16; ++t) R.zr[t] = zs[t * 64]; }
}
template <bool OUT>
__device__ __forceinline__ void hgrn_unit_mfma(const Ctx& C, int l, int hb, int bl, int seg, int h, HgRegs& R, bool hn, int un) {
    LAS unsigned char* Qi = C.lds;
    LAS unsigned char* Ki = Qi + 128 * RS;
    LAS unsigned char* Vi = Ki + 128 * RS;
    LAS float* BL = (LAS float*)(Vi + 128 * RS);
    LAS float* BO = BL + 128 * 68;
    LAS float* TT = BO + 512;
    LAS unsigned char* Si = (LAS unsigned char*)(TT + 512);
    const int tid = C.tid, lane = C.lane, w = C.wave, fr = lane & 15, fq = lane >> 4;
    const size_t rowbase = (size_t)(bl * SEQ + seg * SEGL);
    const float* PBL = C.PB + l * PB_N;
    float* Sg = C.SH + ((size_t)((bl * NSEG + seg) * 4 + h)) * 4096;
    u32x4 (&rq)[2] = R.rq; u32x4 (&rv)[2] = R.rv; float (&sv)[8] = R.sv;
    bf16 zr[16];
#pragma unroll
    for (int t = 0; t < 16; ++t) zr[t] = R.zr[t];
    const float lb = PBL[PB_LB + h * 64 + lane];
    lds_barrier();
#pragma unroll
    for (int i = 0; i < 2; ++i) {
        const int idx = tid + 512 * i, row = idx >> 3, c8 = idx & 7;
        if (OUT) *(LAS u32x4*)(Qi + row * RS + c8 * 16) = rq[i];
        *(LAS u32x4*)(Vi + row * RS + c8 * 16) = rv[i];
    }
    if (OUT) {
        const int v = tid & 63, kg = tid >> 6;
        u32x4 o; o.x = pkbf(sv[0], sv[1]); o.y = pkbf(sv[2], sv[3]); o.z = pkbf(sv[4], sv[5]); o.w = pkbf(sv[6], sv[7]);
        *(LAS u32x4*)(Si + v * RS + kg * 16) = o;
    }
    float kkv[16];
    {
        float cum = 0.f;
#pragma unroll
        for (int t = 0; t < 16; ++t) {
            const float sg = sigmoidf_(bf2f(zr[t])), f = fmaxf(lb, 1e-30f) + (1.f - lb) * sg;
            kkv[t] = (1.f - lb) * (1.f - sg);
            cum += __logf(f);
            BL[(16 * w + t) * 68 + lane] = cum;
            if (OUT) *(LAS bf16*)(Ki + (16 * w + t) * RS + 2 * lane) = (bf16)f2bf(kkv[t]);
        }
        TT[w * 64 + lane] = cum;
    }
    if (hn) hgrn_load<OUT>(C, un >> 7, (un >> 2) & 31, un & 3, R);
    lds_barrier();
    {   float bo = 0.f;
        for (int c = 0; c < w; ++c) bo += TT[c * 64 + lane];
        BO[w * 64 + lane] = bo;
        if (!OUT) {
            float tot = bo;
            for (int c = w; c < 8; ++c) tot += TT[c * 64 + lane];
#pragma unroll
            for (int t = 0; t < 16; ++t) *(LAS bf16*)(Ki + (16 * w + t) * RS + 2 * lane) = (bf16)f2bf(kkv[t] * __expf(tot - bo - BL[(16 * w + t) * 68 + lane]));
            if (w == 0) C.DH[((bl * NSEG + seg) * 4 + h) * 64 + lane] = __expf(tot);
        }
    }
    lds_barrier();
    const f32x4 z4 = {0.f, 0.f, 0.f, 0.f};
    if (!OUT) {
        const int kt = w >> 1, vt0 = (w & 1) * 2;
        f32x4 a0 = z4, a1 = z4;
#pragma unroll
        for (int jb = 0; jb < 4; ++jb) {
            const int j0 = 32 * jb + 8 * fq;
            const bf16x8 Af = trfrag(Ki, j0, j0 + 4, 16 * kt, fr);
            a0 = mfma16(Af, trfrag(Vi, j0, j0 + 4, 16 * vt0, fr), a0);
            a1 = mfma16(Af, trfrag(Vi, j0, j0 + 4, 16 * vt0 + 16, fr), a1);
        }
#pragma unroll
        for (int i = 0; i < 4; ++i) { Sg[(16 * kt + 4 * fq + i) * 64 + 16 * vt0 + fr] = a0[i]; Sg[(16 * kt + 4 * fq + i) * 64 + 16 * vt0 + 16 + fr] = a1[i]; }
        return;
    }
    const int c = w, t0 = 16 * c;
    float pow_[4];
#pragma unroll
    for (int vt = 0; vt < 4; ++vt) pow_[vt] = PBL[PB_HGN + h * 64 + 16 * vt + fr];
    bf16 gq[4][4];
#pragma unroll
    for (int i = 0; i < 4; ++i)
#pragma unroll
        for (int vt = 0; vt < 4; ++vt) gq[i][vt] = C.PROJ[bm_idx((int)rowbase + t0 + 4 * fq + i, 768 + h * 64 + 16 * vt + fr)];
    bf16x8 Qc[2], Qt[2], Qs[2];
    f32x4 bref[2][2], boc[2][2];
#pragma unroll
    for (int ks = 0; ks < 2; ++ks) {
        const int kx = 8 * fq + 32 * ks;
        float q[8]; unpack8(*(const LAS u32x4*)(Qi + (t0 + fr) * RS + 2 * kx), q);
        const f32x4 b0 = *(const LAS f32x4*)(BL + (t0 + fr) * 68 + kx), b1 = *(const LAS f32x4*)(BL + (t0 + fr) * 68 + kx + 4);
        bref[ks][0] = *(const LAS f32x4*)(BL + (t0 + 8) * 68 + kx); bref[ks][1] = *(const LAS f32x4*)(BL + (t0 + 8) * 68 + kx + 4);
        boc[ks][0] = *(const LAS f32x4*)(BO + c * 64 + kx); boc[ks][1] = *(const LAS f32x4*)(BO + c * 64 + kx + 4);
        f32x4 lo, hi;
#pragma unroll
        for (int e = 0; e < 4; ++e) { lo[e] = q[e] * __expf(b0[e]); hi[e] = q[4 + e] * __expf(b1[e]); }
        Qc[ks] = pack8(lo, hi);
#pragma unroll
        for (int e = 0; e < 4; ++e) { lo[e] = q[e] * __expf(b0[e] - bref[ks][0][e]); hi[e] = q[4 + e] * __expf(b1[e] - bref[ks][1][e]); }
        Qt[ks] = pack8(lo, hi);
#pragma unroll
        for (int e = 0; e < 4; ++e) { lo[e] = q[e] * __expf(boc[ks][0][e] + b0[e]); hi[e] = q[4 + e] * __expf(boc[ks][1][e] + b1[e]); }
        Qs[ks] = pack8(lo, hi);
    }
    f32x4 O[4] = {z4, z4, z4, z4};
    for (int jb = 0; jb <= (c >> 1); ++jb) {
        f32x4 st[2];
#pragma unroll
        for (int hf = 0; hf < 2; ++hf) {
            const int u = 2 * jb + hf;
            st[hf] = z4;
            if (u <= c) {
                const bool diag = (u == c);
#pragma unroll
                for (int ks = 0; ks < 2; ++ks) {
                    const int kx = 8 * fq + 32 * ks;
                    float k8[8]; unpack8(*(const LAS u32x4*)(Ki + (16 * u + fr) * RS + 2 * kx), k8);
                    const f32x4 b0 = *(const LAS f32x4*)(BL + (16 * u + fr) * 68 + kx), b1 = *(const LAS f32x4*)(BL + (16 * u + fr) * 68 + kx + 4);
                    f32x4 e0, e1;
                    if (diag) { e0 = bref[ks][0] - b0; e1 = bref[ks][1] - b1; }
                    else { e0 = boc[ks][0] - *(const LAS f32x4*)(BO + u * 64 + kx) - b0; e1 = boc[ks][1] - *(const LAS f32x4*)(BO + u * 64 + kx + 4) - b1; }
                    f32x4 lo, hi;
#pragma unroll
                    for (int e = 0; e < 4; ++e) { lo[e] = k8[e] * __expf(e0[e]); hi[e] = k8[4 + e] * __expf(e1[e]); }
                    st[hf] = mfma16(pack8(lo, hi), diag ? Qt[ks] : Qc[ks], st[hf]);
                }
                if (diag) {
#pragma unroll
                    for (int i = 0; i < 4; ++i) st[hf][i] = (4 * fq + i <= fr) ? st[hf][i] : 0.f;
                }
            }
        }
        const bf16x8 Pf = pack8(st[0], st[1]);
#pragma unroll
        for (int vt = 0; vt < 4; ++vt) O[vt] = mfma16(Pf, trfrag(Vi, 32 * jb + 4 * fq, 32 * jb + 16 + 4 * fq, 16 * vt, fr), O[vt]);
    }
#pragma unroll
    for (int vt = 0; vt < 4; ++vt) {
        O[vt] = mfma16(Qs[0], ldsfrag(Si + (16 * vt + fr) * RS + 16 * fq), O[vt]);
        O[vt] = mfma16(Qs[1], ldsfrag(Si + (16 * vt + fr) * RS + 16 * fq + 64), O[vt]);
    }
    bf16* Y = (bf16*)(C.ws + WS_Y);
    int fqe = fq; asm volatile("" : "+v"(fqe));
#pragma unroll
    for (int i = 0; i < 4; ++i) {
        const float ms = sum16((O[0][i] * O[0][i] + O[1][i] * O[1][i]) + (O[2][i] * O[2][i] + O[3][i] * O[3][i])) * (1.f / 64.f);
        const float rstd = 1.0f / sqrtf(ms + EPS);
        const size_t row = rowbase + t0 + 4 * fqe + i;
#pragma unroll
        for (int vt = 0; vt < 4; ++vt) {
            const int ch = h * 64 + 16 * vt + fr;
            const float g = bf2f(gq[i][vt]);
            Y[row * DM + ch] = (bf16)f2bf(O[vt][i] * rstd * pow_[vt] * sigmoidf_(g));
        }
    }
}

constexpr int LRU_PB_OFF = 114688;
struct LruRegs { u32x4 xr[3]; float gv[16]; };
__device__ __forceinline__ void lru_params_to_lds(const Ctx& C, int l, int n) {
    LAS unsigned char* P = C.lds + LRU_PB_OFF; LAS float* PF = (LAS float*)(P + 2 * 64 * RS);
    const bf16* WT = C.W + (size_t)l * E_LAYER + O_WLRU;
    const float* PBL = C.PB + l * PB_N;
    lds_barrier();
    for (int idx = C.tid; idx < 2 * 64 * 8; idx += 512) { const int gate = idx >> 9, e = (idx >> 3) & 63, c8 = idx & 7;
        *(LAS u32x4*)(P + (gate * 64 + e) * RS + c8 * 16) = *(const u32x4*)(WT + ((size_t)(gate * 4 + n) * 64 + e) * 64 + 8 * c8); }
    if (C.tid < 256) PF[C.tid] = PBL[PB_CW + (C.tid >> 6) * 256 + n * 64 + (C.tid & 63)];
    else { const int k = (C.tid - 256) >> 6, c = C.tid & 63; PF[256 + k * 64 + c] = PBL[(k == 0 ? PB_CB : k == 1 ? PB_BA : k == 2 ? PB_BX : PB_SP) + n * 64 + c]; }
    lds_barrier();
}
template <bool OUT>
__device__ __forceinline__ void lru_load(const Ctx& C, int bl, int seg, int n, LruRegs& R) {
    int tid = C.tid; asm volatile("" : "+v"(tid)); const int lane = tid & 63, w = C.wave; const size_t rowbase = (size_t)(bl * SEQ + seg * SEGL);
    if (OUT) { const bf16* gp = C.PROJ + bm_idx((int)rowbase + 16 * w, 2816 + n * 64 + lane);
#pragma unroll
        for (int t = 0; t < 16; ++t) R.gv[t] = bf2f(gp[t * 64]); }
#pragma unroll
    for (int i = 0; i < 3; ++i) { const int idx = tid + 512 * i, r = (idx >> 3) < 130 ? (idx >> 3) : 130, c8 = idx & 7, t_abs = seg * SEGL - 3 + r;
        R.xr[i] = *(const u32x4*)(C.PROJ + bm_idx(bl * SEQ + (t_abs > 0 ? t_abs : 0), 2560 + n * 64 + 8 * c8)); }
}
template <bool OUT>
__device__ __forceinline__ void lru_unit_mfma(const Ctx& C, int l, int hb, int bl, int seg, int n, LruRegs& R, bool hn, int un) {
    LAS unsigned char* Xi = C.lds;
    LAS unsigned char* XCi = Xi + 132 * RS;
    LAS float* A = (LAS float*)(XCi + 128 * RS);
    LAS float* U = A + 128 * 68;
    LAS float* PC = U + 128 * 68;
    LAS float* HC = PC + 512;
    const int tid = C.tid, lane = C.lane, w = C.wave, fr = lane & 15, fq = lane >> 4;
    const size_t rowbase = (size_t)(bl * SEQ + seg * SEGL);
    if (C.G & 3) lru_params_to_lds(C, l, n);
    const LAS unsigned char* PP = C.lds + LRU_PB_OFF; const LAS float* PF = (const LAS float*)(PP + 2 * 64 * RS);
    float gv[16];
#pragma unroll
    for (int t = 0; t < 16; ++t) gv[t] = OUT ? R.gv[t] : 0.f;
    u32x4 (&xr)[3] = R.xr;
    lds_barrier();
#pragma unroll
    for (int i = 0; i < 3; ++i) { const int idx = tid + 512 * i, r = idx >> 3, c8 = idx & 7; const bool zero = seg * SEGL - 3 + r < 0;
        if (idx < 131 * 8) *(LAS u32x4*)(Xi + r * RS + c8 * 16) = zero ? (u32x4){0u, 0u, 0u, 0u} : xr[i]; }
    if (hn) lru_load<OUT>(C, un >> 7, (un >> 2) & 31, un & 3, R);
    lds_barrier();
    {
        const int t = tid >> 2, c16 = (tid & 3) * 16;
        float acc[16];
#pragma unroll
        for (int e4 = 0; e4 < 4; ++e4) { const f32x4 b = *(const LAS f32x4*)(PF + 256 + c16 + 4 * e4); acc[4 * e4] = b[0]; acc[4 * e4 + 1] = b[1]; acc[4 * e4 + 2] = b[2]; acc[4 * e4 + 3] = b[3]; }
#pragma unroll
        for (int j = 0; j < 4; ++j) {
            float x[16]; unpack8(*(const LAS u32x4*)(Xi + (t + j) * RS + 2 * c16), x); unpack8(*(const LAS u32x4*)(Xi + (t + j) * RS + 2 * c16 + 16), x + 8);
#pragma unroll
            for (int e4 = 0; e4 < 4; ++e4) { const f32x4 wv = *(const LAS f32x4*)(PF + j * 64 + c16 + 4 * e4);
                acc[4 * e4] += wv[0] * x[4 * e4]; acc[4 * e4 + 1] += wv[1] * x[4 * e4 + 1]; acc[4 * e4 + 2] += wv[2] * x[4 * e4 + 2]; acc[4 * e4 + 3] += wv[3] * x[4 * e4 + 3]; }
        }
        u32x4 o0, o1; o0.x = pkbf(acc[0], acc[1]); o0.y = pkbf(acc[2], acc[3]); o0.z = pkbf(acc[4], acc[5]); o0.w = pkbf(acc[6], acc[7]);
        o1.x = pkbf(acc[8], acc[9]); o1.y = pkbf(acc[10], acc[11]); o1.z = pkbf(acc[12], acc[13]); o1.w = pkbf(acc[14], acc[15]);
        *(LAS u32x4*)(XCi + t * RS + 2 * c16) = o0; *(LAS u32x4*)(XCi + t * RS + 2 * c16 + 16) = o1;
    }
    lds_barrier();
    {
        const f32x4 z4 = {0.f, 0.f, 0.f, 0.f};
        const bf16x8 Xf0 = ldsfrag(XCi + (16 * w + fr) * RS + 16 * fq), Xf1 = ldsfrag(XCi + (16 * w + fr) * RS + 16 * fq + 64);
#pragma unroll
        for (int et = 0; et < 4; ++et) {
            const int e = 16 * et + fr;
            const LAS unsigned char* wa = PP + (0 * 64 + e) * RS + 16 * fq;
            const LAS unsigned char* wx = PP + (1 * 64 + e) * RS + 16 * fq;
            f32x4 ra = mfma16(Xf0, ldsfrag(wa), z4); ra = mfma16(Xf1, ldsfrag(wa + 64), ra);
            f32x4 ia = mfma16(Xf0, ldsfrag(wx), z4); ia = mfma16(Xf1, ldsfrag(wx + 64), ia);
            const float ba = PF[256 + 64 + e], bx = PF[256 + 128 + e], sp = PF[256 + 192 + e];
#pragma unroll
            for (int i = 0; i < 4; ++i) {
                const int t = 16 * w + 4 * fq + i;
                const float r = sigmoidf_(ra[i] + ba), ig = sigmoidf_(ia[i] + bx), xc = bf2f(*(const LAS bf16*)(XCi + t * RS + 2 * e));
                const float la = -8.0f * r * sp;
                A[t * 68 + e] = __expf(la);
                const float x2 = 2.0f * la;
                const float om = x2 > -0.25f ? -x2 * (1.0f + x2 * (0.5f + x2 * (0.16666667f + x2 * (0.041666668f + x2 * 0.0083333338f)))) : 1.0f - __expf(x2);
                U[t * 68 + e] = __builtin_amdgcn_sqrtf(om) * (ig * xc);
            }
        }
    }
    lds_barrier();
    {
        float P = 1.f, hl = 0.f;
#pragma unroll
        for (int t = 0; t < 16; ++t) { const float a = A[(16 * w + t) * 68 + lane], u = U[(16 * w + t) * 68 + lane]; hl = a * hl + u; P *= a; }
        PC[w * 64 + lane] = P; HC[w * 64 + lane] = hl;
    }
    lds_barrier();
    const int sidx = (bl * NSEG + seg) * 256 + n * 64 + lane;
    if (!OUT) {
        if (w == 0) { float hh = 0.f, P = 1.f;
#pragma unroll
            for (int c = 0; c < 8; ++c) { hh = PC[c * 64 + lane] * hh + HC[c * 64 + lane]; P *= PC[c * 64 + lane]; }
            C.HEND[sidx] = hh; C.PEND[sidx] = P; }
        return;
    }
    float hh = C.HEND[sidx];
    for (int c = 0; c < w; ++c) hh = PC[c * 64 + lane] * hh + HC[c * 64 + lane];
    bf16* Y = (bf16*)(C.ws + WS_Y);
#pragma unroll
    for (int t = 0; t < 16; ++t) {
        hh = A[(16 * w + t) * 68 + lane] * hh + U[(16 * w + t) * 68 + lane];
        Y[(rowbase + 16 * w + t) * DM + 768 + n * 64 + lane] = (bf16)f2bf(hh * gelu_tanh(gv[t]));
    }
}

#define UNIT_LOOP(Regs, loadf, unitf) { Regs R; int u = C.bid; if (u < BATCH * 128) loadf(C, u >> 7, (u >> 2) & 31, u & 3, R); \
    for (; u < BATCH * 128; u += C.G) { const int un = u + C.G; unitf(C, l, hb, u >> 7, (u >> 2) & 31, u & 3, R, un < BATCH * 128, un); } }
__device__ __forceinline__ void mix_local_phase(const Ctx& C, int l, int hb) {
    UNIT_LOOP(HgRegs, hgrn_load<false>, hgrn_unit_mfma<false>)
    UNIT_LOOP(RetRegs, ret_load<false>, ret_unit_mfma<false>)
    lru_params_to_lds(C, l, C.bid & 3);
    UNIT_LOOP(LruRegs, lru_load<false>, lru_unit_mfma<false>)
}
__device__ __forceinline__ void mix_scan_phase(const Ctx& C, int l, int hb) {
    for (int gi = C.bid * 512 + C.tid; gi < 2 * BH * 16384; gi += C.G * 512) {
        const int mixer = gi / (BH * 16384), e = gi % (BH * 16384), bl = e >> 14, hh = (e >> 12) & 3, kv = e & 4095, k = kv >> 6;
        float* S = (mixer == 0 ? C.SH : C.SR) + ((size_t)(bl * NSEG * 4 + hh)) * 4096 + kv;
        const float* D = C.DH + (bl * NSEG * 4 + hh) * 64 + k;
        float g128 = 1.0f - exp2f(-5.0f - (float)hh);
#pragma unroll
        for (int i = 0; i < 7; ++i) g128 *= g128;
        float sl[NSEG], dd[NSEG];
#pragma unroll
        for (int seg = 0; seg < NSEG; ++seg) { sl[seg] = S[(size_t)seg * 4 * 4096]; dd[seg] = mixer == 0 ? D[seg * 4 * 64] : g128; }
        float carry = 0.f;
#pragma unroll
        for (int seg = 0; seg < NSEG; ++seg) { S[(size_t)seg * 4 * 4096] = carry; carry = dd[seg] * carry + sl[seg]; }
    }
    for (int gi = C.bid * 512 + C.tid; gi < BH * 256; gi += C.G * 512) {
        const int bl = gi >> 8, c = gi & 255; float he[NSEG], pe[NSEG];
#pragma unroll
        for (int seg = 0; seg < NSEG; ++seg) { he[seg] = C.HEND[(bl * NSEG + seg) * 256 + c]; pe[seg] = C.PEND[(bl * NSEG + seg) * 256 + c]; }
        float carry = 0.f;
#pragma unroll
        for (int seg = 0; seg < NSEG; ++seg) { C.HEND[(bl * NSEG + seg) * 256 + c] = carry; carry = pe[seg] * carry + he[seg]; }
    }
    for (int u = C.bid; u < BATCH * 64; u += C.G) swa_unit_mfma(C, l, hb, u >> 6, (u >> 1) & 31, u & 1);
}
__device__ __forceinline__ void mix_out_phase(const Ctx& C, int l, int hb) {
    UNIT_LOOP(HgRegs, hgrn_load<true>, hgrn_unit_mfma<true>)
    UNIT_LOOP(RetRegs, ret_load<true>, ret_unit_mfma<true>)
    lru_params_to_lds(C, l, C.bid & 3);
    UNIT_LOOP(LruRegs, lru_load<true>, lru_unit_mfma<true>)
}

__global__ void __launch_bounds__(512, 2) fwd(Args args) {
    extern __shared__ __attribute__((aligned(16))) unsigned char lds_raw[];
    Ctx K;
    K.lds = (LAS unsigned char*)lds_raw;
    K.tid = 0; K.lane = 0; K.wave = __builtin_amdgcn_readfirstlane(threadIdx.x >> 6); K.G = gridDim.x; K.bid = blockIdx.x;
    K.in.t = (InTab)__builtin_amdgcn_kernarg_segment_ptr(); K.out = args.out; K.ws = args.ws;
    volatile LAS unsigned* MISC = (volatile LAS unsigned*)(K.lds + LDSCTL_OFF);
    if (threadIdx.x < 64) MISC[threadIdx.x] = 0u;
    __syncthreads();
    const int lo = args.ph_lo, hi = args.ph_hi;
    XcdBarrier bar; bar.bar = (unsigned*)(args.ws + WS_CTL) + CW_BAR; bar.x = 0; bar.st = MISC + 8; bar.wave = K.wave;
    if (hi - lo > 1) bar = xcd_barrier_post((unsigned*)(args.ws + WS_CTL) + CW_BAR, MISC + 8, K.wave);
    int ph = 0;
#define PH_BEGIN if (ph >= lo && ph < hi) { const Ctx C = phase_ctx(K);
#define PH_END   if (ph + 1 < hi) xcd_barrier(bar); } ++ph;

    PH_BEGIN
        LAS float* scr = (LAS float*)(C.lds + C.wave * 16384);
        const int gw = C.bid * 8 + C.wave, NGW = C.G * 8;
        {
            float ra[32], rb[32];
            int it = gw; ItemDesc da = decode_item(C, it < DEPTH * IT_LAYER ? it : 0), db = da;
            if (it < DEPTH * IT_LAYER) tr_load(da, ra, C.lane);
#pragma unroll 1
            while (it < DEPTH * IT_LAYER) {
                const int i1 = it + NGW, i2 = it + 2 * NGW;
                if (i1 < DEPTH * IT_LAYER) { db = decode_item(C, i1); tr_load(db, rb, C.lane); }
                tr_finish(da, ra, scr, C.lane);
                if (i1 >= DEPTH * IT_LAYER) break;
                if (i2 < DEPTH * IT_LAYER) { da = decode_item(C, i2); tr_load(da, ra, C.lane); }
                tr_finish(db, rb, scr, C.lane);
                it = i2;
            }
        }
        for (int e = C.bid * 512 + C.tid; e < DEPTH * PB_N; e += C.G * 512) {
            const int pl = e / PB_N, o = e % PB_N; float v = 0.f;
            if (o < 256) v = C.in[I_HGN][pl * 256 + o];
            else if (o < 512) v = C.in[I_RGW][pl * 256 + o - 256];
            else if (o < 768) v = C.in[I_RGB][pl * 256 + o - 512];
            else if (o < 832) v = C.in[I_QN][pl * 64 + o - 768];
            else if (o < 896) v = C.in[I_KN][pl * 64 + o - 832];
            else if (o < 900) v = C.in[I_SINK][pl * 4 + o - 896];
            else if (o < 1024) v = 0.f;
            else if (o < 2048) v = C.in[I_CW][pl * 1024 + o - 1024];
            else if (o < 2304) v = C.in[I_CB][pl * 256 + o - 2048];
            else if (o < 2560) v = C.in[I_BA][pl * 256 + o - 2304];
            else if (o < 2816) v = C.in[I_BX][pl * 256 + o - 2560];
            else if (o < 3072) v = log1pf(expf(-C.in[I_LAM][pl * 256 + o - 2816]));
            else if (o < 3328) v = hgrn_lb(C.in[I_LBL], pl, o - 3072);
            else if (o < 4096) v = 0.f;
            else v = C.in[I_GBIAS][pl * 4096 + o - 4096];
            C.PB[e] = v;
        }
        for (int e = C.bid * 512 + C.tid; e < DEPTH * (int)E_WLRU; e += C.G * 512) {
            const int pl = e / (int)E_WLRU, o = e % (int)E_WLRU, gate = o >> 14, n = (o >> 12) & 3, ee = (o >> 6) & 63, c = o & 63;
            const float v = (gate ? C.in[I_WX] : C.in[I_WA])[((size_t)(pl * 4 + n) * 64 + c) * 64 + ee];
            (C.W + (size_t)pl * E_LAYER + O_WLRU)[o] = (bf16)f2bf(v);
        }
        {
            float* ssq0 = (float*)(C.ws + WS_SSQ);
            for (int m = gw; m < MT; m += 4 * NGW) {
                f32x4 v[4][4];
#pragma unroll
                for (int rr = 0; rr < 4; ++rr)
#pragma unroll
                    for (int j = 0; j < 4; ++j) v[rr][j] = ((const f32x4*)(C.in[I_X] + (size_t)(m + rr * NGW) * DM) + C.lane)[64 * j];
#pragma unroll
                for (int rr = 0; rr < 4; ++rr) {
                    const int mm = m + rr * NGW; unsigned long long* o8 = (unsigned long long*)(C.HN + (size_t)mm * DM) + C.lane; float q = 0.f;
#pragma unroll
                    for (int j = 0; j < 4; ++j) { const f32x4 x = v[rr][j]; q += (x.x * x.x + x.y * x.y) + (x.z * x.z + x.w * x.w); o8[64 * j] = (unsigned long long)pk2(x.x, x.y) | ((unsigned long long)pk2(x.z, x.w) << 32); }
                    q = wave_sum(q, C.lane);
                    if (C.lane < 16) ssq0[(size_t)mm * 16 + C.lane] = C.lane == 0 ? q : 0.f;
                }
            }
        }
    PH_END

#pragma unroll 1
    for (int l = 0; l < DEPTH; ++l) {
#pragma unroll 1
        for (int f = 0; f < 2; ++f) {
            PH_BEGIN
#ifndef NO_UP
                pg8::Gemm g{DM, DM, DM}; pg8::StaticOrder S; S.init(MT, NGU, C.G, C.bid, C.HN, DM, C.W + (size_t)l * E_LAYER + (f == 0 ? O_WGU1 : O_WGU2), DM);
                pg8::EpiSwiglu E{C.ws, (unsigned)((l * 3 + (f == 0 ? 0 : 2)) * MT)};
                pg8::gemm_phase<pg8::EpiSwiglu, pg8::StaticOrder, true>(C.lds, C.tid, g, S, E);
#endif
            PH_END
            PH_BEGIN
#ifndef NO_DOWN
                pg8::Gemm g{DFF, DFF, DFF}; pg8::StaticOrder S; S.init(MT, DM, C.G, C.bid, C.HID, DFF, C.W + (size_t)l * E_LAYER + (f == 0 ? O_WD1 : O_WD2), DFF);
                const bool feeds = (f == 0) || (l + 1 < DEPTH);
                pg8::EpiResid E{C.out, 0.5f, C.ws, 0u, (unsigned)((f == 0 ? l * 3 + 1 : (feeds ? (l + 1) * 3 : 0)) * MT), feeds, !feeds};
                pg8::gemm_phase<pg8::EpiResid, pg8::StaticOrder, true>(C.lds, C.tid, g, S, E);
#endif
            PH_END
            if (f == 0) {
                const int hb = 0;
                PH_BEGIN
#ifndef NO_WIN
                    pg8::Gemm g{DM, DM, DM}; pg8::StaticOrder S; S.init(MT, NPROJ, C.G, C.bid, C.HN, DM, C.W + (size_t)l * E_LAYER + O_WIN, DM);
                    pg8::EpiWin E{C.ws, (unsigned)(l * PB_N + PB_GB), (unsigned)((l * 3 + 1) * MT), false};
                    pg8::gemm_phase<pg8::EpiWin, pg8::StaticOrder, true>(C.lds, C.tid, g, S, E);
#endif
                PH_END
                PH_BEGIN
                    mix_local_phase(C, l, hb);
                PH_END
                PH_BEGIN
                    mix_scan_phase(C, l, hb);
                PH_END
                PH_BEGIN
                    mix_out_phase(C, l, hb);
                PH_END
                PH_BEGIN
#ifndef NO_WIN
                    pg8::Gemm g{DM, DM, DM}; pg8::StaticOrder S; S.init(MT, NGATE, C.G, C.bid, C.HN, DM, C.W + (size_t)l * E_LAYER + O_WIN + (size_t)NPROJ * DM, DM);
                    pg8::EpiWin E{C.ws, (unsigned)(l * PB_N + PB_GB), (unsigned)((l * 3 + 1) * MT), true};
                    pg8::gemm_phase<pg8::EpiWin, pg8::StaticOrder, true>(C.lds, C.tid, g, S, E);
#endif
                PH_END
                PH_BEGIN
#ifndef NO_MERGE
                    pg8::Gemm g{DM, DM, DM}; pg8::MergeOrder S; S.init(MT, C.G, C.bid, C.ws + WS_Y, C.W + (size_t)l * E_LAYER + O_WB);
                    pg8::EpiMerge E{C.ws};
                    pg8::gemm_phase<pg8::EpiMerge, pg8::MergeOrder, true, true>(C.lds, C.tid, g, S, E);
#endif
                PH_END
                PH_BEGIN
#ifndef NO_WOUT
                    pg8::Gemm g{DM, DM, DM}; pg8::StaticOrder S; S.init(MT, DM, C.G, C.bid, C.MERGED, DM, C.W + (size_t)l * E_LAYER + O_WOUT, DM);
                    pg8::EpiResid E{C.out, 1.0f, C.ws, 0u, (unsigned)((l * 3 + 2) * MT), true, false};
                    pg8::gemm_phase<pg8::EpiResid, pg8::StaticOrder, true>(C.lds, C.tid, g, S, E);
#endif
                PH_END
            }
        }
    }
#undef PH_BEGIN
#undef PH_END
}
constexpr int N_PHASES = 1 + DEPTH * (2 + 7 + 2);

extern "C" void kernel_launch(void* const* d_in, const int* in_sizes, int n_in, void* d_out, int out_size, void* d_ws, size_t ws_size, hipStream_t stream) {
    static int grid = 0;
    if (grid == 0) {
        if (n_in != 28 || in_sizes[0] != MT * DM || out_size != MT * DM || ws_size < WS_END2) { fprintf(stderr, "kernel_launch: unexpected shapes (n_in %d, x %d, out %d, ws %zu < %zu); nothing launched\n", n_in, n_in > 0 ? in_sizes[0] : -1, out_size, ws_size, (size_t)WS_END2); grid = -1; return; }
        int dev = 0, cus = 0, per_cu = 0;
        if (hipGetDevice(&dev) != hipSuccess || hipDeviceGetAttribute(&cus, hipDeviceAttributeMultiprocessorCount, dev) != hipSuccess) { grid = -1; return; }
        if (hipFuncSetAttribute((const void*)fwd, hipFuncAttributeMaxDynamicSharedMemorySize, LDS_BYTES) != hipSuccess) { fprintf(stderr, "kernel_launch: hipFuncSetAttribute failed\n"); grid = -1; return; }
        if (hipOccupancyMaxActiveBlocksPerMultiprocessor(&per_cu, (const void*)fwd, 512, LDS_BYTES) != hipSuccess || per_cu < 1) fprintf(stderr, "kernel_launch: occupancy query reports %d\n", per_cu);
        (void)hipGetLastError();
        grid = cus;
    }
    if (grid < 0) return;
    (void)hipMemsetAsync((char*)d_ws + WS_CTL, 0, CTL_ZERO_BYTES, stream);
    Args a{};
    for (int i = 0; i < 28; ++i) a.in[i] = (const float*)d_in[i];
    a.out = (float*)d_out; a.ws = (unsigned char*)d_ws;
#if MK_MULTI
    for (int p = 0; p < N_PHASES; ++p) { a.ph_lo = p; a.ph_hi = p + 1; hipLaunchKernelGGL(fwd, dim3(grid), dim3(512), LDS_BYTES, stream, a); }
#else
    a.ph_lo = 0; a.ph_hi = N_PHASES;
    hipLaunchKernelGGL(fwd, dim3(grid), dim3(512), LDS_BYTES, stream, a);
#endif
}
```

```cpp
#include <hip/hip_runtime.h>
#include <cstdio>
#include <cstdint>

#ifndef MK_MULTI
#define MK_MULTI 0
#endif

#define LAS __attribute__((address_space(3)))
#define GAS __attribute__((address_space(1)))
typedef unsigned short bf16;
typedef short bf16x8 __attribute__((ext_vector_type(8)));
typedef float f32x4 __attribute__((ext_vector_type(4)));
typedef float f32x2 __attribute__((ext_vector_type(2)));
typedef unsigned u32x4 __attribute__((ext_vector_type(4)));
typedef unsigned u32x2 __attribute__((ext_vector_type(2)));
typedef int i32x4 __attribute__((ext_vector_type(4)));

constexpr int DM = 1024, BATCH = 8, SEQ = 4096, DEPTH = 2, DFF = 2816, DIN = 7168, NPROJ = 3072, NGATE = 4096;
constexpr int MT = BATCH * SEQ;
constexpr int MH = MT;
constexpr int BH = BATCH;
constexpr int NSEG = 32, SEGL = 128;
constexpr int NGU = 2 * DFF;
constexpr float EPS = 1e-6f;

constexpr size_t MiB = 1u << 20;
constexpr size_t WS_CTL = 0, CTL_ZERO_BYTES = 32 * 1024;
constexpr size_t E_WGU = (size_t)NGU * DM, E_WD = (size_t)DM * DFF, E_WIN = (size_t)DIN * DM, E_WB = (size_t)4 * DM * 256, E_WOUT = (size_t)DM * DM;
constexpr size_t O_WGU1 = 0, O_WD1 = O_WGU1 + E_WGU, O_WIN = O_WD1 + E_WD, O_WB = O_WIN + E_WIN, O_WOUT = O_WB + E_WB, O_WGU2 = O_WOUT + E_WOUT, O_WD2 = O_WGU2 + E_WGU;
constexpr size_t O_WLRU = O_WD2 + E_WD, E_WLRU = 2 * 4 * 64 * 64;
constexpr size_t E_LAYER = O_WLRU + E_WLRU;
constexpr size_t WS_W = 2 * MiB;
constexpr size_t WS_PB = 104 * MiB + 512 * 1024;
constexpr int PB_N = 8192, PB_HGN = 0, PB_RGW = 256, PB_RGB = 512, PB_QN = 768, PB_KN = 832, PB_SINK = 896, PB_CW = 1024, PB_CB = 2048, PB_BA = 2304, PB_BX = 2560, PB_SP = 2816, PB_LB = 3072, PB_GB = 4096;
constexpr size_t WS_HN = 105 * MiB;
constexpr size_t WS_U = 169 * MiB;
constexpr size_t WS_HID = WS_U;
constexpr size_t WS_PROJ = WS_U;
constexpr size_t WS_GATES = WS_U;
constexpr size_t WS_MERGED = WS_U + 128 * MiB;
constexpr size_t WS_SH = WS_U + 192 * MiB;
constexpr size_t WS_SR = WS_U + 208 * MiB;
constexpr size_t WS_Y = WS_U + 224 * MiB;
constexpr size_t WS_DH = WS_U + 288 * MiB;
constexpr size_t WS_HEND = WS_DH + 256 * 1024;
constexpr size_t WS_PEND = WS_HEND + 256 * 1024;
constexpr size_t WS_END = WS_U + 289 * MiB;
static_assert(WS_W + 2 * E_LAYER * 2 <= WS_PB && WS_PB + DEPTH * PB_N * 4 <= WS_HN && WS_HN + (size_t)MT * DM * 2 <= WS_U && WS_HID + (size_t)MT * DFF * 2 <= WS_END, "ws map");
static_assert(WS_PROJ + (size_t)MT * NPROJ * 2 <= WS_SH && WS_GATES + (size_t)MT * NGATE <= WS_MERGED && WS_MERGED + (size_t)MT * DM * 2 <= WS_SH, "mixer-stage overlays");
constexpr int CW_BAR = 4096;
static_assert((CW_BAR + 3456) * 4 <= (int)CTL_ZERO_BYTES, "barrier words inside the per-call memset");
constexpr size_t WS_SSQ = WS_END;
constexpr size_t WS_END2 = WS_SSQ + (size_t)3 * DEPTH * MT * 16 * 4;
constexpr size_t WS_XQ = WS_END2;
constexpr size_t WS_WQ = WS_XQ + (size_t)MT * DM;
constexpr size_t WS_ROWF = WS_WQ + (size_t)NGATE * DM;
constexpr size_t WS_CSC = WS_ROWF + (size_t)MT * 4;
constexpr size_t WS_END3 = WS_CSC + (size_t)NGATE * 4;
constexpr int RING_BYTES = 131072;
constexpr int LDSCTL_OFF = 143360;
constexpr int LDS_BYTES = 147456;

__device__ __forceinline__ int lane_id() { int l; asm volatile("v_mbcnt_lo_u32_b32 %0, -1, 0\n\tv_mbcnt_hi_u32_b32 %0, -1, %0" : "=v"(l)); return l; }
__device__ __forceinline__ float bf2f(unsigned h) { return __uint_as_float(h << 16); }
__device__ __forceinline__ unsigned f2bf(float f) { unsigned u = __float_as_uint(f); return (u + 0x7fffu + ((u >> 16) & 1u)) >> 16; }
__device__ __forceinline__ unsigned pk2(float lo, float hi) { return f2bf(lo) | (f2bf(hi) << 16); }
__device__ __forceinline__ unsigned cvt_pk_bf16(float lo, float hi) { unsigned r; asm volatile("v_cvt_pk_bf16_f32 %0, %1, %2" : "=v"(r) : "v"(lo), "v"(hi)); return r; }
__device__ __forceinline__ float sigmoidf_(float x) { return __builtin_amdgcn_rcpf(1.0f + __expf(-x)); }
template <int O> __device__ __forceinline__ float swz_xor(float v) { return __int_as_float(__builtin_amdgcn_ds_swizzle(__float_as_int(v), (O << 10) | 0x1f)); }
__device__ __forceinline__ float wave_sum(float v, int lane) {
    v += swz_xor<1>(v); v += swz_xor<2>(v); v += swz_xor<4>(v); v += swz_xor<8>(v); v += swz_xor<16>(v);
    v += __int_as_float(__builtin_amdgcn_ds_bpermute((lane ^ 32) << 2, __float_as_int(v)));
    return v;
}
__device__ __forceinline__ void unpack8(const u32x4 v, float* o) {
    o[0] = __uint_as_float(v.x << 16); o[1] = __uint_as_float(v.x & 0xffff0000u);
    o[2] = __uint_as_float(v.y << 16); o[3] = __uint_as_float(v.y & 0xffff0000u);
    o[4] = __uint_as_float(v.z << 16); o[5] = __uint_as_float(v.z & 0xffff0000u);
    o[6] = __uint_as_float(v.w << 16); o[7] = __uint_as_float(v.w & 0xffff0000u);
}

struct RsRaw { f32x4 a, b, c, d; };
__device__ __forceinline__ RsRaw rs_load(const float* part) { RsRaw r; r.a = *(const f32x4*)part; r.b = *(const f32x4*)(part + 4); r.c = *(const f32x4*)(part + 8); r.d = *(const f32x4*)(part + 12); return r; }
__device__ __forceinline__ float rs_finish(const RsRaw& r) {
    const float s = (((r.a[0] + r.a[1]) + (r.a[2] + r.a[3])) + ((r.b[0] + r.b[1]) + (r.b[2] + r.b[3]))) + (((r.c[0] + r.c[1]) + (r.c[2] + r.c[3])) + ((r.d[0] + r.d[1]) + (r.d[2] + r.d[3])));
    return 1.0f / sqrtf(s * (1.f / DM) + EPS);
}
namespace pg8 {
constexpr int BM = 256, BK = 64, HALF = 128, HTB = HALF * BK * 2, STAGE_BYTES = 8 * HTB, NXCD = 8, WGM = 8;
__host__ __device__ __forceinline__ int lds_byte(int r, int c) { const int st = (r >> 4) * 2 + (c >> 5), rr = r & 15, cc = c & 31, ob = rr * 64 + cc * 2; return st * 1024 + (ob ^ (((ob >> 9) & 1) << 5)); }
__host__ __device__ __forceinline__ void stage_rc(int b, int& R, int& C) { const int st = b / 1024, sb = b % 1024, swz = sb ^ (((sb >> 9) & 1) << 5); R = (st >> 1) * 16 + swz / 64; C = (st & 1) * 32 + (swz % 64) / 2; }
__host__ __device__ __forceinline__ int perm32(int rho) { const int n = rho >> 4, i = rho & 15; return 8 * (i >> 2) + 4 * n + (i & 3); }

struct Unit { int pm, pn, aux; const char* a; const char* b; };
struct Gemm { int lda, ldb, K; };

struct StaticOrder {
    int nM, nN, nwg, G, c; const char* A; const char* Bt; size_t ta, tb;
    __device__ void init(int M, int N, int G_, int c_, const void* A_, int lda, const void* Bt_, int ldb) {
        nM = M / BM; nN = N / BM; nwg = nM * nN; G = G_; c = c_; A = (const char*)A_; Bt = (const char*)Bt_; ta = (size_t)BM * lda * 2; tb = (size_t)BM * ldb * 2; }
    __device__ bool next(int i, Unit& u) const {
        const long L = (long)i * G + c; if (L >= nwg) return false;
        int wgid = (int)L; { const int q = nwg / NXCD, r = nwg % NXCD, xcd = wgid % NXCD, off = wgid / NXCD; wgid = (xcd < r ? xcd * (q + 1) : r * (q + 1) + (xcd - r) * q) + off; }
        const int nig = WGM * nN, gid = wgid / nig, fm = gid * WGM, gsz = (nM - fm) < WGM ? (nM - fm) : WGM;
        u.pm = fm + ((wgid % nig) % gsz); u.pn = (wgid % nig) / gsz; u.aux = 0; u.a = A + (size_t)u.pm * ta; u.b = Bt + (size_t)u.pn * tb; return true;
    }
};
struct MergeOrder {
    int nM, nN, nwg, G, c; const char* Y; const char* Wb;
    __device__ void init(int M, int G_, int c_, const void* Y_, const void* Wb_) { nM = M / BM; nN = DM / HALF; nwg = nM * nN; G = G_; c = c_; Y = (const char*)Y_; Wb = (const char*)Wb_; }
    __device__ bool next(int i, Unit& u) const {
        const long L = (long)i * G + c; if (L >= nwg) return false;
        int wgid = (int)L; { const int q = nwg / NXCD, r = nwg % NXCD, xcd = wgid % NXCD, off = wgid / NXCD; wgid = (xcd < r ? xcd * (q + 1) : r * (q + 1) + (xcd - r) * q) + off; }
        const int nig = WGM * nN, gid = wgid / nig, fm = gid * WGM, gsz = (nM - fm) < WGM ? (nM - fm) : WGM;
        u.pm = fm + ((wgid % nig) % gsz); u.pn = (wgid % nig) / gsz; u.aux = 0;
        u.a = Y + (size_t)u.pm * BM * DM * 2; u.b = Wb + (size_t)u.pn * HALF * DM * 2; return true;
    }
};

struct EpiSwiglu {
    static constexpr bool PERM = true;
    static constexpr bool NEEDS_RS = true, RS_PLAIN = false, I8 = false;
    unsigned char* ws; unsigned ssq_off;
    __device__ __forceinline__ const float* rs_ptr(int row) const { return (const float*)(ws + WS_SSQ) + ((size_t)ssq_off + row) * 16; }
    __device__ __forceinline__ void operator()(const f32x4 (&acc)[2][2][4][2], const Unit& u, int wr, int wc, int fr, int fq, const LAS float* rsl) const {
        const int row0 = u.pm * BM + wr * 64 + fr, col0 = u.pn * HALF + wc * 32 + 8 * fq;
        bf16* O = (bf16*)(ws + WS_HID);
#pragma unroll
        for (int ai = 0; ai < 2; ++ai)
#pragma unroll
            for (int m = 0; m < 4; ++m) {
                const int row = row0 + ai * HALF + m * 16;
                const float rs = rsl[ai * HALF + wr * 64 + m * 16 + fr];
                float o[8];
#pragma unroll
                for (int n = 0; n < 2; ++n)
#pragma unroll
                    for (int e = 0; e < 4; ++e) { const float g = acc[ai][0][m][n][e] * rs, up = acc[ai][1][m][n][e] * rs; o[n * 4 + e] = g * up * __builtin_amdgcn_rcpf(1.0f + __expf(-g)); }
                u32x4 w; w.x = cvt_pk_bf16(o[0], o[1]); w.y = cvt_pk_bf16(o[2], o[3]); w.z = cvt_pk_bf16(o[4], o[5]); w.w = cvt_pk_bf16(o[6], o[7]);
                __builtin_nontemporal_store(w, (u32x4*)(O + (size_t)row * DFF + col0)); }
    }
};
struct EpiResid {
    static constexpr bool PERM = true;
    static constexpr bool NEEDS_RS = false, RS_PLAIN = false, I8 = false;
    float* out; float scale; unsigned char* ws; unsigned x_off, ssq_off; bool feed, fin;
    __device__ __forceinline__ const float* rs_ptr(int) const { return nullptr; }
    __device__ __forceinline__ void operator()(const f32x4 (&acc)[2][2][4][2], const Unit& u, int wr, int wc, int fr, int fq, const LAS float*) const {
        const int row0 = u.pm * BM + wr * 64 + fr, col0 = u.pn * BM + wc * 32 + 8 * fq;
        const int lane = fq * 16 + fr;
        bf16* xb = (bf16*)(ws + WS_HN) + x_off; float* ssq = (float*)(ws + WS_SSQ) + (size_t)ssq_off * 16;
#pragma unroll
        for (int ai = 0; ai < 2; ++ai)
#pragma unroll
            for (int m = 0; m < 4; ++m) { const size_t off = (size_t)(row0 + ai * HALF + m * 16) * DM + col0; float q = 0.f;
#pragma unroll
                for (int bj = 0; bj < 2; ++bj) {
                    float x[8]; unpack8(*(const u32x4*)(xb + off + bj * HALF), x);
#pragma unroll
                    for (int e = 0; e < 4; ++e) { x[e] += acc[ai][bj][m][0][e] * scale; x[4 + e] += acc[ai][bj][m][1][e] * scale; }
                    if (fin) { *(f32x4*)(out + x_off + off + bj * HALF) = (f32x4){x[0], x[1], x[2], x[3]}; *(f32x4*)(out + x_off + off + bj * HALF + 4) = (f32x4){x[4], x[5], x[6], x[7]}; }
                    else { u32x4 w; w.x = cvt_pk_bf16(x[0], x[1]); w.y = cvt_pk_bf16(x[2], x[3]); w.z = cvt_pk_bf16(x[4], x[5]); w.w = cvt_pk_bf16(x[6], x[7]); *(u32x4*)(xb + off + bj * HALF) = w;
                        if (feed) { float r[8]; unpack8(w, r);
#pragma unroll
                            for (int e = 0; e < 8; ++e) q += r[e] * r[e]; } } }
                if (feed) { q += swz_xor<16>(q); q += __int_as_float(__builtin_amdgcn_ds_bpermute((lane ^ 32) << 2, __float_as_int(q)));
                    if (fq == 0) ssq[(size_t)(row0 + ai * HALF + m * 16) * 16 + u.pn * 4 + wc] = q; } }
    }
};
struct EpiWin {
    static constexpr bool PERM = true;
    static constexpr bool NEEDS_RS = true, RS_PLAIN = false, I8 = false;
    unsigned char* ws; unsigned pb_off, ssq_off; bool gphase;
    __device__ __forceinline__ const float* rs_ptr(int row) const { return (const float*)(ws + WS_SSQ) + ((size_t)ssq_off + row) * 16; }
    __device__ __forceinline__ void operator()(const f32x4 (&acc)[2][2][4][2], const Unit& u, int wr, int wc, int fr, int fq, const LAS float* rsl) const {
        const int row0 = u.pm * BM + wr * 64 + fr;
        bf16* proj = (bf16*)(ws + WS_PROJ); bf16* gates = (bf16*)(ws + WS_GATES); const float* gbias = (const float*)(ws + WS_PB) + pb_off;
        const bool isg = gphase;
        const int colt = u.pn * BM + wc * 32 + 8 * fq;
        f32x4 bv[2][2];
#pragma unroll
        for (int bj = 0; bj < 2; ++bj)
#pragma unroll
            for (int n = 0; n < 2; ++n) bv[bj][n] = isg ? *(const f32x4*)(gbias + colt + bj * HALF + 4 * n) : (f32x4){0.f, 0.f, 0.f, 0.f};
#pragma unroll
        for (int ai = 0; ai < 2; ++ai)
#pragma unroll
            for (int m = 0; m < 4; ++m) { const int rr = row0 + ai * HALF + m * 16;
                const float rs = rsl[ai * HALF + wr * 64 + m * 16 + fr];
#pragma unroll
                for (int bj = 0; bj < 2; ++bj) { f32x4 v0 = acc[ai][bj][m][0] * rs + bv[bj][0], v1 = acc[ai][bj][m][1] * rs + bv[bj][1];
                    if (isg) {
#pragma unroll
                        for (int e = 0; e < 4; ++e) { v0[e] = __builtin_amdgcn_rcpf(1.0f + __expf(-v0[e])); v1[e] = __builtin_amdgcn_rcpf(1.0f + __expf(-v1[e])); } }
                    const size_t eidx = ((size_t)((colt + bj * HALF) >> 6) * MH + rr) * 64 + ((colt + bj * HALF) & 63);
                    if (isg) {
                        u32x2 w = {0u, 0u};
                        w.x = __builtin_amdgcn_cvt_pk_u8_f32(v0[0] * 255.0f, 0, w.x); w.x = __builtin_amdgcn_cvt_pk_u8_f32(v0[1] * 255.0f, 1, w.x); w.x = __builtin_amdgcn_cvt_pk_u8_f32(v0[2] * 255.0f, 2, w.x); w.x = __builtin_amdgcn_cvt_pk_u8_f32(v0[3] * 255.0f, 3, w.x);
                        w.y = __builtin_amdgcn_cvt_pk_u8_f32(v1[0] * 255.0f, 0, w.y); w.y = __builtin_amdgcn_cvt_pk_u8_f32(v1[1] * 255.0f, 1, w.y); w.y = __builtin_amdgcn_cvt_pk_u8_f32(v1[2] * 255.0f, 2, w.y); w.y = __builtin_amdgcn_cvt_pk_u8_f32(v1[3] * 255.0f, 3, w.y);
                        __builtin_nontemporal_store(w, (u32x2*)((unsigned char*)gates + eidx));
                    } else {
                        u32x4 w; w.x = cvt_pk_bf16(v0[0], v0[1]); w.y = cvt_pk_bf16(v0[2], v0[3]); w.z = cvt_pk_bf16(v1[0], v1[1]); w.w = cvt_pk_bf16(v1[2], v1[3]);
                        __builtin_nontemporal_store(w, (u32x4*)(proj + eidx)); } } }
    }
};
struct EpiGate8 {
    static constexpr bool PERM = true;
    static constexpr bool NEEDS_RS = true, RS_PLAIN = true, I8 = true;
    unsigned char* ws; unsigned pb_off;
    __device__ __forceinline__ const float* rs_ptr(int row) const { return (const float*)(ws + WS_ROWF) + row; }
    __device__ __forceinline__ void operator()(const f32x4 (&acc)[2][2][4][2], const Unit& u, int wr, int wc, int fr, int fq, const LAS float* rsl) const {
        const int row0 = u.pm * BM + wr * 64 + fr;
        unsigned char* gates = ws + WS_GATES; const float* gbias = (const float*)(ws + WS_PB) + pb_off; const float* csc = (const float*)(ws + WS_CSC);
        const int colt = u.pn * BM + wc * 32 + 8 * fq;
        f32x4 bv[2][2], cv[2][2];
#pragma unroll
        for (int bj = 0; bj < 2; ++bj)
#pragma unroll
            for (int n = 0; n < 2; ++n) { bv[bj][n] = *(const f32x4*)(gbias + colt + bj * HALF + 4 * n); cv[bj][n] = *(const f32x4*)(csc + colt + bj * HALF + 4 * n); }
#pragma unroll
        for (int ai = 0; ai < 2; ++ai)
#pragma unroll
            for (int m = 0; m < 4; ++m) { const int rr = row0 + ai * HALF + m * 16;
                const float rs = rsl[ai * HALF + wr * 64 + m * 16 + fr];
#pragma unroll
                for (int bj = 0; bj < 2; ++bj) { f32x4 v0, v1;
#pragma unroll
                    for (int e = 0; e < 4; ++e) {
                        v0[e] = (float)__float_as_int(acc[ai][bj][m][0][e]) * (rs * cv[bj][0][e]) + bv[bj][0][e]; v1[e] = (float)__float_as_int(acc[ai][bj][m][1][e]) * (rs * cv[bj][1][e]) + bv[bj][1][e];
                        v0[e] = __builtin_amdgcn_rcpf(1.0f + __expf(-v0[e])); v1[e] = __builtin_amdgcn_rcpf(1.0f + __expf(-v1[e])); }
                    const size_t eidx = ((size_t)((colt + bj * HALF) >> 6) * MH + rr) * 64 + ((colt + bj * HALF) & 63);
                    u32x2 w = {0u, 0u};
                    w.x = __builtin_amdgcn_cvt_pk_u8_f32(v0[0] * 255.0f, 0, w.x); w.x = __builtin_amdgcn_cvt_pk_u8_f32(v0[1] * 255.0f, 1, w.x); w.x = __builtin_amdgcn_cvt_pk_u8_f32(v0[2] * 255.0f, 2, w.x); w.x = __builtin_amdgcn_cvt_pk_u8_f32(v0[3] * 255.0f, 3, w.x);
                    w.y = __builtin_amdgcn_cvt_pk_u8_f32(v1[0] * 255.0f, 0, w.y); w.y = __builtin_amdgcn_cvt_pk_u8_f32(v1[1] * 255.0f, 1, w.y); w.y = __builtin_amdgcn_cvt_pk_u8_f32(v1[2] * 255.0f, 2, w.y); w.y = __builtin_amdgcn_cvt_pk_u8_f32(v1[3] * 255.0f, 3, w.y);
                    __builtin_nontemporal_store(w, (u32x2*)(gates + eidx)); } }
    }
};
struct EpiMerge {
    static constexpr bool PERM = true;
    static constexpr bool NEEDS_RS = false, RS_PLAIN = false, I8 = false;
    unsigned char* ws;
    __device__ __forceinline__ const float* rs_ptr(int) const { return nullptr; }
    __device__ __forceinline__ void gate_load(u32x2 (&gv)[2][4], const Unit& u, int nb, int wr, int wc, int fr, int fq) const {
        const int row0 = u.pm * BM + wr * 64 + fr, col0 = u.pn * HALF + wc * 32 + 8 * fq;
        const unsigned char* gates = (const unsigned char*)(ws + WS_GATES);
#pragma unroll
        for (int ai = 0; ai < 2; ++ai)
#pragma unroll
            for (int m = 0; m < 4; ++m) gv[ai][m] = *(const u32x2*)(gates + (((size_t)((nb * DM + col0) >> 6) * MH + (row0 + ai * HALF + m * 16)) * 64 + ((nb * DM + col0) & 63)));
    }
    __device__ __forceinline__ void hook(f32x4 (&acc)[2][2][4][2], const u32x2 (&gv)[2][4]) const {
#pragma unroll
        for (int ai = 0; ai < 2; ++ai)
#pragma unroll
            for (int m = 0; m < 4; ++m) {
#pragma unroll
                for (int e = 0; e < 4; ++e) { acc[ai][1][m][0][e] += (float)((gv[ai][m].x >> (8 * e)) & 0xffu) * acc[ai][0][m][0][e]; acc[ai][1][m][1][e] += (float)((gv[ai][m].y >> (8 * e)) & 0xffu) * acc[ai][0][m][1][e]; }
                acc[ai][0][m][0] = (f32x4){0.f, 0.f, 0.f, 0.f}; acc[ai][0][m][1] = (f32x4){0.f, 0.f, 0.f, 0.f}; }
    }
    __device__ __forceinline__ void operator()(const f32x4 (&acc)[2][2][4][2], const Unit& u, int wr, int wc, int fr, int fq, const LAS float*) const {
        const int row0 = u.pm * BM + wr * 64 + fr, col0 = u.pn * HALF + wc * 32 + 8 * fq;
        bf16* merged = (bf16*)(ws + WS_MERGED);
#pragma unroll
        for (int ai = 0; ai < 2; ++ai)
#pragma unroll
            for (int m = 0; m < 4; ++m) { const f32x4 v0 = acc[ai][1][m][0] * (1.0f / 255.0f), v1 = acc[ai][1][m][1] * (1.0f / 255.0f);
                u32x4 w; w.x = cvt_pk_bf16(v0[0], v0[1]); w.y = cvt_pk_bf16(v0[2], v0[3]); w.z = cvt_pk_bf16(v1[0], v1[1]); w.w = cvt_pk_bf16(v1[2], v1[3]);
                *(u32x4*)(merged + (size_t)(row0 + ai * HALF + m * 16) * DM + col0) = w; }
    }
};

template <bool I8> __device__ __forceinline__ f32x4 mma1(const bf16x8 b, const bf16x8 a, const f32x4 c) {
    if constexpr (I8) return __builtin_bit_cast(f32x4, __builtin_amdgcn_mfma_i32_16x16x64_i8(__builtin_bit_cast(i32x4, b), __builtin_bit_cast(i32x4, a), __builtin_bit_cast(i32x4, c), 0, 0, 0));
    else return __builtin_amdgcn_mfma_f32_16x16x32_bf16(b, a, c, 0, 0, 0);
}
template <class Epi, class Sched, bool ALIGN_EPI, bool HALFN = false>
__device__ __forceinline__ void gemm_phase(LAS unsigned char* lds, const int tid, const Gemm g, const Sched& S, const Epi& E) {
    const int wid = __builtin_amdgcn_readfirstlane(tid >> 6), lane = tid & 63, wr = wid >> 2, wc = wid & 3, fr = lane & 15, fq = lane >> 4;
    int K = g.K; asm volatile("" : "+s"(K));
    const int nt = K / BK;
    unsigned voffA[2], voffB[2];
#pragma unroll
    for (int i = 0; i < 2; ++i) { int R, C; stage_rc(tid * 16 + i * 8192, R, C); const int Rb = Epi::PERM ? ((R & ~31) + perm32(R & 31)) : R;
        voffA[i] = (unsigned)(R * g.lda + C) * 2u; voffB[i] = (unsigned)(Rb * g.ldb + C) * 2u; }
    const size_t kstep = (size_t)(BK * 2);
    const size_t hstepA = (size_t)HALF * g.lda * 2, hstepB = (size_t)HALF * g.ldb * 2;
    const unsigned ldsw = (unsigned)wid * 1024u;
    const int aoff = lds_byte(wr * 64 + fr, fq * 8), boff = lds_byte(wc * 32 + fr, fq * 8);
#define PG8_SA(b, h) (((b) * 2 + (h)) * HTB)
#define PG8_SB(b, h) ((4 + (b) * 2 + (h)) * HTB)
#define PG8_STAGE(bufoff, gbase, voff) do { _Pragma("unroll") for (int _i = 0; _i < 2; ++_i) \
        __builtin_amdgcn_global_load_lds((const unsigned*)((const char*)(gbase) + (voff)[_i]), (LAS unsigned*)(lds + (bufoff) + ldsw + _i * 8192), 16, 0, 0); } while (0)
#define PG8_LDA(dst, b, h) do { _Pragma("unroll") for (int m = 0; m < 4; ++m) _Pragma("unroll") for (int k = 0; k < 2; ++k) dst[m][k] = *(const LAS bf16x8*)(lds + PG8_SA(b, h) + aoff + m * 2048 + k * 1024); } while (0)
#define PG8_LDB(dst, b, h) do { _Pragma("unroll") for (int n = 0; n < 2; ++n) _Pragma("unroll") for (int k = 0; k < 2; ++k) dst[n][k] = *(const LAS bf16x8*)(lds + PG8_SB(b, h) + boff + n * 2048 + k * 1024); } while (0)
#define PG8_MMA(ai, bj, At, Bt) do { __builtin_amdgcn_s_setprio(1); _Pragma("unroll") for (int m = 0; m < 4; ++m) _Pragma("unroll") for (int n = 0; n < 2; ++n) _Pragma("unroll") for (int k = 0; k < 2; ++k) \
        acc[ai][bj][m][n] = mma1<Epi::I8>(Bt[n][k], At[m][k], acc[ai][bj][m][n]); __builtin_amdgcn_s_setprio(0); } while (0)
#define PG8_WAIT_V(n) asm volatile("s_waitcnt vmcnt(" #n ")" ::: "memory")
#define PG8_WAIT_L(n) asm volatile("s_waitcnt lgkmcnt(" #n ")" ::: "memory")
#define PG8_BAR __builtin_amdgcn_s_barrier()
#define PG8_SCHED __builtin_amdgcn_sched_barrier(0)
    Unit cur, nxt; int ui = 0;
    if (!S.next(0, cur)) return;
    LAS float* RS = (LAS float*)(lds + STAGE_BYTES);
    if constexpr (Epi::NEEDS_RS) { if (tid < 256) { if constexpr (Epi::RS_PLAIN) RS[tid] = *E.rs_ptr(cur.pm * BM + tid); else RS[tid] = rs_finish(rs_load(E.rs_ptr(cur.pm * BM + tid))); } }
    u32x2 gv[2][4];
    if constexpr (HALFN) E.gate_load(gv, cur, 0, wr, wc, fr, fq);
    f32x4 acc[2][2][4][2];
#pragma unroll
    for (int a = 0; a < 2; ++a)
#pragma unroll
        for (int b = 0; b < 2; ++b)
#pragma unroll
            for (int m = 0; m < 4; ++m)
#pragma unroll
                for (int n = 0; n < 2; ++n) acc[a][b][m][n] = (f32x4){0.f, 0.f, 0.f, 0.f};
    bf16x8 At[4][2], B0[2][2], B1[2][2];
    const char* cA = cur.a; const char* cB = cur.b;
    PG8_STAGE(PG8_SB(0, 0), cB, voffB); PG8_STAGE(PG8_SB(0, 1), cB + hstepB, voffB); PG8_STAGE(PG8_SA(0, 0), cA, voffA); PG8_STAGE(PG8_SA(0, 1), cA + hstepA, voffA);
    if (wr == 1) PG8_BAR;
    PG8_WAIT_V(2); PG8_BAR;
    PG8_STAGE(PG8_SB(1, 0), cB + kstep, voffB); PG8_STAGE(PG8_SA(1, 0), cA + kstep, voffA); PG8_STAGE(PG8_SB(1, 1), cB + hstepB + kstep, voffB);
    PG8_WAIT_V(6); PG8_BAR;
    for (;;) {
        const bool has_next = S.next(ui + 1, nxt);
        const char* nA = has_next ? nxt.a : cA; const char* nB = has_next ? nxt.b : cB;
        for (int t = 0; t < nt; t += 2) {
            const bool last = (t == nt - 2);
            const char* a1 = cA + (size_t)(t + 1) * kstep;
            const char* a2 = last ? nA : cA + (size_t)(t + 2) * kstep; const char* b2 = last ? nB : cB + (size_t)(t + 2) * kstep;
            const char* a3 = a2 + kstep; const char* b3 = b2 + kstep;
            PG8_LDB(B0, 0, 0); if constexpr (!HALFN) PG8_LDB(B1, 0, 1); PG8_SCHED; PG8_LDA(At, 0, 0); PG8_STAGE(PG8_SA(1, 1), a1 + hstepA, voffA);
            PG8_WAIT_V(8); PG8_WAIT_L(0); PG8_BAR; PG8_MMA(0, 0, At, B0); if constexpr (!HALFN) PG8_MMA(0, 1, At, B1); PG8_BAR; PG8_SCHED;
            PG8_LDA(At, 0, 1); PG8_STAGE(PG8_SB(0, 0), b2, voffB); PG8_STAGE(PG8_SB(0, 1), b2 + hstepB, voffB); PG8_STAGE(PG8_SA(0, 0), a2, voffA);
            PG8_WAIT_V(8); PG8_WAIT_L(0); PG8_BAR; PG8_MMA(1, 0, At, B0); if constexpr (!HALFN) PG8_MMA(1, 1, At, B1); PG8_BAR; PG8_SCHED;
            PG8_LDB(B0, 1, 0); if constexpr (!HALFN) PG8_LDB(B1, 1, 1); PG8_SCHED; PG8_LDA(At, 1, 0); PG8_STAGE(PG8_SA(0, 1), a2 + hstepA, voffA);
            PG8_WAIT_V(8); PG8_WAIT_L(0); PG8_BAR; PG8_MMA(0, 0, At, B0); if constexpr (!HALFN) PG8_MMA(0, 1, At, B1); PG8_BAR; PG8_SCHED;
            PG8_LDA(At, 1, 1); PG8_STAGE(PG8_SB(1, 0), b3, voffB); PG8_STAGE(PG8_SB(1, 1), b3 + hstepB, voffB); PG8_STAGE(PG8_SA(1, 0), a3, voffA);
            PG8_WAIT_V(8); PG8_WAIT_L(0); PG8_BAR; PG8_MMA(1, 0, At, B0); if constexpr (!HALFN) PG8_MMA(1, 1, At, B1); PG8_BAR; PG8_SCHED;
            if constexpr (HALFN) { if ((t & 3) == 2) {
                E.hook(acc, gv);
                const int el = lane_id(); int ewr = wr, ewc = wc; asm volatile("" : "+s"(ewr), "+s"(ewc));
                if (!last) E.gate_load(gv, cur, (t >> 2) + 1, ewr, ewc, el & 15, el >> 4);
                else if (has_next) E.gate_load(gv, nxt, 0, ewr, ewc, el & 15, el >> 4); } }
        }
        if constexpr (ALIGN_EPI) { if (wr == 0) PG8_BAR; }
        { const int el = lane_id(); const int efr = el & 15, efq = el >> 4; int ewr = wr, ewc = wc; asm volatile("" : "+s"(ewr), "+s"(ewc));
          RsRaw nraw; nraw.a = nraw.b = nraw.c = nraw.d = (f32x4){0.f, 0.f, 0.f, 0.f};
          if constexpr (Epi::NEEDS_RS) { if (has_next && ewr == 0) { if constexpr (Epi::RS_PLAIN) nraw.a[0] = *E.rs_ptr(nxt.pm * BM + ewc * 64 + el); else nraw = rs_load(E.rs_ptr(nxt.pm * BM + ewc * 64 + el)); } }
          E(acc, cur, ewr, ewc, efr, efq, RS + (ui & 1) * 256);
          if constexpr (Epi::NEEDS_RS) { if (has_next && ewr == 0) { if constexpr (Epi::RS_PLAIN) RS[((ui + 1) & 1) * 256 + ewc * 64 + el] = nraw.a[0]; else RS[((ui + 1) & 1) * 256 + ewc * 64 + el] = rs_finish(nraw); } } }
        if (!has_next) break;
#pragma unroll
        for (int a = 0; a < 2; ++a)
#pragma unroll
            for (int b = 0; b < 2; ++b)
#pragma unroll
                for (int m = 0; m < 4; ++m)
#pragma unroll
                    for (int n = 0; n < 2; ++n) acc[a][b][m][n] = (f32x4){0.f, 0.f, 0.f, 0.f};
        cur = nxt; cA = nA; cB = nB; ++ui;
        if constexpr (ALIGN_EPI) { if (wr == 1) PG8_BAR; }
    }
    PG8_WAIT_V(0);
    if constexpr (!ALIGN_EPI) { if (wr == 0) PG8_BAR; }
    PG8_BAR;
#undef PG8_SA
#undef PG8_SB
#undef PG8_STAGE
#undef PG8_LDA
#undef PG8_LDB
#undef PG8_MMA
#undef PG8_WAIT_V
#undef PG8_WAIT_L
#undef PG8_BAR
#undef PG8_SCHED
}
}

#define XB_TMO      128
#define XB_XCNT(j)  (256  + 64 * (j))
#define XB_XSUB(j)  (1280 + 64 * (j))
#define XB_XGEN(j)  (2304 + 64 * (j))
#define XB_TOP      3328
#define XB_TOPGEN   3392
#define XCD_BAR_WORDS 3456
#define XB_SPIN_CAP (1u << 18)
__device__ __forceinline__ unsigned xb_ld(unsigned* p)              { return __hip_atomic_load(p, __ATOMIC_RELAXED, __HIP_MEMORY_SCOPE_AGENT); }
__device__ __forceinline__ unsigned xb_add(unsigned* p, unsigned v) { return __hip_atomic_fetch_add(p, v, __ATOMIC_RELAXED, __HIP_MEMORY_SCOPE_AGENT); }
__device__ __forceinline__ unsigned xb_xcc_id() { return (unsigned)__builtin_amdgcn_s_getreg((3 << 11) | 20) & 0xFu; }
#define XB_SPIN(cond, bar) do { unsigned _sp = 0; while (cond) { __builtin_amdgcn_s_sleep(1); \
    if ((++_sp & 255u) == 0u) { if (xb_ld(&(bar)[XB_TMO])) break; if (_sp > XB_SPIN_CAP) { atomicAdd(&(bar)[XB_TMO], 1u); break; } } } } while (0)
struct XcdBarrier { unsigned* bar; unsigned x; volatile LAS unsigned* st; int wave; };
__device__ __forceinline__ XcdBarrier xcd_barrier_post(unsigned* bar, volatile LAS unsigned* st, int wave) {
    XcdBarrier b; b.bar = bar; b.x = xb_xcc_id(); b.st = st; b.wave = wave;
    if (wave == 0 && lane_id() == 0) (void)xb_add(&bar[XB_XCNT(b.x)], 1u);
    return b;
}
__device__ __forceinline__ void xcd_barrier_complete(unsigned* bar, unsigned x, unsigned& nloc, unsigned& nx) {
    const unsigned G = gridDim.x * gridDim.y * gridDim.z;
    unsigned sum, cnt, mine, sp = 0u;
    for (;;) {
        sum = 0u; cnt = 0u; mine = 0u;
#pragma unroll
        for (unsigned j = 0; j < 16; ++j) { const unsigned c = xb_ld(&bar[XB_XCNT(j)]); sum += c; cnt += (c > 0u) ? 1u : 0u; mine = (j == x) ? c : mine; }
        if (sum == G) break;
        __builtin_amdgcn_s_sleep(1);
        if ((++sp & 255u) == 0u) { if (xb_ld(&bar[XB_TMO])) break; if (sp > XB_SPIN_CAP) { atomicAdd(&bar[XB_TMO], 1u); break; } }
    }
    nloc = mine > 0u ? mine : 1u; nx = cnt > 0u ? cnt : 1u;
}
__device__ __forceinline__ void xcd_barrier(const XcdBarrier& b) {
    asm volatile("s_waitcnt vmcnt(0)" ::: "memory");
    __syncthreads();
    if (b.wave == 0 && lane_id() == 0) {
        unsigned* bar = b.bar;
        __builtin_amdgcn_s_waitcnt(0);
        unsigned nloc = b.st[0], nx = b.st[1];
        if (nloc == 0u) { xcd_barrier_complete(bar, b.x, nloc, nx); b.st[0] = nloc; b.st[1] = nx; }
        const unsigned old = xb_add(&bar[XB_XSUB(b.x)], 1u);
        const unsigned gen = old / nloc;
        if (old + 1u == (gen + 1u) * nloc) {
            __builtin_amdgcn_fence(__ATOMIC_RELEASE, "agent");
            asm volatile("s_waitcnt vmcnt(0)" ::: "memory");
            const unsigned og = xb_add(&bar[XB_TOP], 1u);
            const unsigned tg = og / nx;
            if (og + 1u == (tg + 1u) * nx) xb_add(&bar[XB_TOPGEN], 1u);
            else XB_SPIN(xb_ld(&bar[XB_TOPGEN]) == tg, bar);
            __builtin_amdgcn_fence(__ATOMIC_ACQUIRE, "agent");
            xb_add(&bar[XB_XGEN(b.x)], 1u);
            asm volatile("s_waitcnt vmcnt(0)" ::: "memory");
        } else {
            XB_SPIN(xb_ld(&bar[XB_XGEN(b.x)]) == gen, bar);
            __builtin_amdgcn_fence(__ATOMIC_ACQUIRE, "agent");
            asm volatile("s_waitcnt vmcnt(0)" ::: "memory");
        }
    }
    __syncthreads();
}

struct Args { const float* in[28]; float* out; unsigned char* ws; int ph_lo, ph_hi; };
enum { I_X = 0, I_F1N, I_F1G, I_F1U, I_F1D, I_MIXN, I_WIN, I_GBIAS, I_LBL, I_HGN, I_RGW, I_RGB, I_QN, I_KN, I_SINK, I_CW, I_CB, I_WA, I_BA, I_WX, I_BX, I_LAM, I_WBR, I_WOUT, I_F2N, I_F2G, I_F2U, I_F2D };
typedef const float* CFP;
typedef const __attribute__((address_space(4))) CFP* InTab;
template <class T> __device__ __forceinline__ T* as_global(T* p) { return (T*)(GAS T*)p; }
struct InPtrs { InTab t; __device__ __forceinline__ const float* operator[](int i) const { return as_global(t[i]); } };
__host__ __device__ __forceinline__ size_t bm_idx(int row, int col) { return ((size_t)(col >> 6) * MH + row) * 64 + (col & 63); }
struct Ctx {
    LAS unsigned char* lds; int tid, lane, wave, G, bid;
    InPtrs in; float* out; unsigned char* ws;
    bf16 *W, *HN, *HID, *PROJ, *GATES, *MERGED; float *SH, *SR, *HLOC, *PCUM, *DH, *HEND, *PEND, *PB;
};
__device__ __forceinline__ Ctx phase_ctx(const Ctx& K) {
    Ctx C; C.lds = K.lds; C.G = K.G; C.bid = K.bid;
    int lane = lane_id(), wave = K.wave; InTab in = K.in.t; GAS float* outg = (GAS float*)K.out; GAS unsigned char* wsg = (GAS unsigned char*)K.ws;
    asm volatile("" : "+v"(lane)); asm volatile("" : "+s"(wave)); asm volatile("" : "+s"(in)); asm volatile("" : "+s"(outg)); asm volatile("" : "+s"(wsg));
    float* out = (float*)outg; unsigned char* ws = (unsigned char*)wsg;
    C.tid = wave * 64 + lane; C.lane = lane; C.wave = wave; C.in.t = in; C.out = out; C.ws = ws;
    C.W = (bf16*)(ws + WS_W); C.HN = (bf16*)(ws + WS_HN); C.HID = (bf16*)(ws + WS_HID); C.PROJ = (bf16*)(ws + WS_PROJ); C.GATES = (bf16*)(ws + WS_GATES); C.MERGED = (bf16*)(ws + WS_MERGED);
    C.SH = (float*)(ws + WS_SH); C.SR = (float*)(ws + WS_SR); C.HLOC = nullptr; C.PCUM = nullptr; C.DH = (float*)(ws + WS_DH); C.HEND = (float*)(ws + WS_HEND); C.PEND = (float*)(ws + WS_PEND); C.PB = (float*)(ws + WS_PB);
    return C;
}

struct ItemDesc { const float* src; bf16* dst; const float* gain; int ldw, ldt, k0, n0, orow; };
__device__ __forceinline__ void tr_load(const ItemDesc& d, float (&r)[32], int lane) {
#pragma unroll
    for (int i = 0; i < 32; ++i) r[i] = d.src[(size_t)(d.k0 + 2 * i + (lane >> 5)) * d.ldw + d.n0 + (lane & 31)];
}
__device__ __forceinline__ void tr_finish(const ItemDesc& d, const float (&r)[32], LAS float* scr, int lane) {
#pragma unroll
    for (int i = 0; i < 32; ++i) scr[(2 * i + (lane >> 5)) * 33 + (lane & 31)] = r[i];
    asm volatile("s_waitcnt lgkmcnt(0)" ::: "memory");
    const int c = lane & 7;
    f32x4 g0 = {1.f, 1.f, 1.f, 1.f}, g1 = g0;
    if (d.gain) { g0 = *(const f32x4*)(d.gain + d.k0 + 8 * c); g1 = *(const f32x4*)(d.gain + d.k0 + 8 * c + 4); }
#pragma unroll
    for (int j = 0; j < 4; ++j) { const int n = (lane >> 3) + 8 * j; const LAS float* s = scr + (8 * c) * 33 + n;
        u32x4 o; o.x = pk2(s[0 * 33] * g0[0], s[1 * 33] * g0[1]); o.y = pk2(s[2 * 33] * g0[2], s[3 * 33] * g0[3]); o.z = pk2(s[4 * 33] * g1[0], s[5 * 33] * g1[1]); o.w = pk2(s[6 * 33] * g1[2], s[7 * 33] * g1[3]);
        *(u32x4*)(d.dst + (size_t)(d.n0 + d.orow + n) * d.ldt + d.k0 + 8 * c) = o; }
    asm volatile("s_waitcnt lgkmcnt(0)" ::: "memory");
}
constexpr int IT_FF = 16 * 88, IT_FFN = 6 * IT_FF, IT_WIN = 16 * 224, IT_WB = 512, IT_WOUT = 512, IT_LAYER = IT_FFN + IT_WIN + IT_WB + IT_WOUT;
static_assert((DFF / 64) * (DM / 32) == IT_FF, "wd items == gate items");
__device__ __forceinline__ ItemDesc decode_item(const Ctx& C, int it) {
    ItemDesc d; d.gain = nullptr; d.orow = 0;
    const int l = it / IT_LAYER; int r = it % IT_LAYER;
    bf16* WL = C.W + (size_t)l * E_LAYER;
    if (r < IT_FFN) {
        const int s = r / IT_FF, q = r % IT_FF, f = s / 3, kind = s % 3;
        if (kind < 2) {
            const int kb = q / 88, nb = q % 88, n0 = 32 * nb;
            d.src = (f == 0 ? (kind == 0 ? C.in[I_F1G] : C.in[I_F1U]) : (kind == 0 ? C.in[I_F2G] : C.in[I_F2U])) + (size_t)l * DM * DFF;
            d.ldw = DFF; d.k0 = 64 * kb; d.n0 = n0; d.dst = WL + (f == 0 ? O_WGU1 : O_WGU2); d.ldt = DM; d.orow = 256 * (n0 / 128) + (n0 % 128) + 128 * kind - n0;
            d.gain = (f == 0 ? C.in[I_F1N] : C.in[I_F2N]) + l * DM;
        } else {
            const int kb = q / 32, nb = q % 32;
            d.src = (f == 0 ? C.in[I_F1D] : C.in[I_F2D]) + (size_t)l * DFF * DM; d.ldw = DM; d.k0 = 64 * kb; d.n0 = 32 * nb; d.dst = WL + (f == 0 ? O_WD1 : O_WD2); d.ldt = DFF;
        }
        return d;
    }
    r -= IT_FFN;
    if (r < IT_WIN) { const int kb = r / 224, nb = r % 224; d.src = C.in[I_WIN] + (size_t)l * DM * DIN; d.ldw = DIN; d.k0 = 64 * kb; d.n0 = 32 * nb; d.dst = WL + O_WIN; d.ldt = DM; d.gain = C.in[I_MIXN] + l * DM; return d; }
    r -= IT_WIN;
    if (r < IT_WB) { const int n = r / 128, q = r % 128, kb = q / 32, nb = q % 32; d.src = C.in[I_WBR] + (size_t)(l * 4 + n) * 256 * DM; d.ldw = DM; d.k0 = 64 * kb; d.n0 = 32 * nb; d.dst = WL + O_WB + (size_t)n * 256; d.ldt = DM; return d; }
    r -= IT_WB;
    { const int kb = r / 32, nb = r % 32; d.src = C.in[I_WOUT] + (size_t)l * DM * DM; d.ldw = DM; d.k0 = 64 * kb; d.n0 = 32 * nb; d.dst = WL + O_WOUT; d.ldt = DM; }
    return d;
}

__device__ __forceinline__ void norm_row(const float* xrow, const float* w, bf16* orow, int lane) {
    const f32x4* xr = (const f32x4*)xrow + lane; const f32x4* wr = (const f32x4*)w + lane;
    f32x4 v[4]; float s = 0.f;
#pragma unroll
    for (int j = 0; j < 4; ++j) { v[j] = xr[64 * j]; s += (v[j].x * v[j].x + v[j].y * v[j].y) + (v[j].z * v[j].z + v[j].w * v[j].w); }
    const float rstd = 1.0f / sqrtf(wave_sum(s, lane) * (1.f / DM) + EPS);
    unsigned long long* o8 = (unsigned long long*)orow + lane;
#pragma unroll
    for (int j = 0; j < 4; ++j) { const f32x4 g = wr[64 * j]; o8[64 * j] = (unsigned long long)pk2(v[j].x * rstd * g.x, v[j].y * rstd * g.y) | ((unsigned long long)pk2(v[j].z * rstd * g.z, v[j].w * rstd * g.w) << 32); }
}
__device__ __forceinline__ void norm_phase(const Ctx& C, const float* x, const float* w, bf16* out) {
    const int gw = C.bid * 8 + C.wave, NGW = C.G * 8;
    for (int m = gw; m < MT; m += NGW) norm_row(x + (size_t)m * DM, w, out + (size_t)m * DM, C.lane);
}

__device__ __forceinline__ float hgrn_lb(const float* logits, int l, int w) {
    if (l == 0) return 0.f;
    float mx = logits[w];
#pragma unroll
    for (int j = 1; j < DEPTH; ++j) mx = fmaxf(mx, logits[j * 256 + w]);
    float den = 0.f, num = 0.f;
#pragma unroll
    for (int j = 0; j < DEPTH; ++j) { const float e = __expf(logits[j * 256 + w] - mx); den += e; if (j >= 1 && j <= l) num += e; }
    return num / den;
}

__device__ __forceinline__ void lds_barrier() { asm volatile("s_waitcnt lgkmcnt(0)\n\ts_barrier" ::: "memory"); }
typedef short s16x4 __attribute__((ext_vector_type(4)));
typedef __bf16 bf16x2_t __attribute__((ext_vector_type(2)));
__device__ __forceinline__ unsigned pkbf(float a, float b) { const f32x2 f = {a, b}; return __builtin_bit_cast(unsigned, __builtin_convertvector(f, bf16x2_t)); }
__device__ __forceinline__ bf16x8 pack8(const f32x4 lo, const f32x4 hi) { u32x4 p; p.x = pkbf(lo[0], lo[1]); p.y = pkbf(lo[2], lo[3]); p.z = pkbf(hi[0], hi[1]); p.w = pkbf(hi[2], hi[3]); return __builtin_bit_cast(bf16x8, p); }
__device__ __forceinline__ f32x4 mfma16(const bf16x8 a, const bf16x8 b, const f32x4 c) { return __builtin_amdgcn_mfma_f32_16x16x32_bf16(a, b, c, 0, 0, 0); }
__device__ __forceinline__ bf16x8 ldsfrag(const LAS unsigned char* p) { return *(const LAS bf16x8*)p; }
constexpr int RS = 144;
__device__ __forceinline__ bf16x8 trfrag(const LAS unsigned char* img, int r0, int r1, int c0, int fr) {
    const int q = fr >> 2, p = fr & 3;
    const s16x4 lo = __builtin_amdgcn_ds_read_tr16_b64_v4i16((LAS s16x4*)(img + (r0 + q) * RS + (c0 + 4 * p) * 2));
    const s16x4 hi = __builtin_amdgcn_ds_read_tr16_b64_v4i16((LAS s16x4*)(img + (r1 + q) * RS + (c0 + 4 * p) * 2));
    return __builtin_shufflevector(lo, hi, 0, 1, 2, 3, 4, 5, 6, 7);
}
__device__ __forceinline__ float sum16(float v) { v += swz_xor<1>(v); v += swz_xor<2>(v); v += swz_xor<4>(v); v += swz_xor<8>(v); return v; }
__device__ __forceinline__ float xor32f(float v, int lane) { return __int_as_float(__builtin_amdgcn_ds_bpermute((lane ^ 32) << 2, __float_as_int(v))); }
__device__ __forceinline__ float sum4g(float v, int lane) { v += swz_xor<16>(v); v += xor32f(v, lane); return v; }
__device__ __forceinline__ float max4g(float v, int lane) { v = fmaxf(v, swz_xor<16>(v)); v = fmaxf(v, xor32f(v, lane)); return v; }

struct RetRegs { u32x4 rq[2], rk[2], rv[2]; float s[8]; };
template <bool OUT>
__device__ __forceinline__ void ret_load(const Ctx& C, int bl, int seg, int h, RetRegs& R) {
    int tid = C.tid; asm volatile("" : "+v"(tid));
    const size_t rowbase = (size_t)(bl * SEQ + seg * SEGL);
    const float* Sg = C.SR + ((size_t)((bl * NSEG + seg) * 4 + h)) * 4096;
#pragma unroll
    for (int i = 0; i < 2; ++i) {
        const int idx = tid + 512 * i, row = idx >> 3, c8 = idx & 7, prow = (int)rowbase + row;
        if (OUT) R.rq[i] = *(const u32x4*)(C.PROJ + bm_idx(prow, 1024 + h * 64 + 8 * c8));
        R.rk[i] = *(const u32x4*)(C.PROJ + bm_idx(prow, 1280 + h * 64 + 8 * c8));
        R.rv[i] = *(const u32x4*)(C.PROJ + bm_idx(prow, 1536 + h * 64 + 8 * c8));
    }
    if (OUT) {
#pragma unroll
        for (int e = 0; e < 8; ++e) R.s[e] = Sg[(8 * (tid >> 6) + e) * 64 + (tid & 63)];
    }
}
template <bool OUT>
__device__ __forceinline__ void ret_unit_mfma(const Ctx& C, int l, int hb, int bl, int seg, int h, RetRegs& R, bool hn, int un) {
    LAS unsigned char* Qi = C.lds;
    LAS unsigned char* Ki = Qi + 128 * RS;
    LAS unsigned char* Vi = Ki + 128 * RS;
    LAS unsigned char* Si = Vi + 128 * RS;
    const int tid = C.tid, lane = C.lane, w = C.wave, fr = lane & 15, fq = lane >> 4;
    const size_t rowbase = (size_t)(bl * SEQ + seg * SEGL);
    const float lg = __log2f(1.0f - exp2f(-5.0f - (float)h));
    float* Sg = C.SR + ((size_t)((bl * NSEG + seg) * 4 + h)) * 4096;
    u32x4 (&rq)[2] = R.rq; u32x4 (&rk)[2] = R.rk; u32x4 (&rv)[2] = R.rv; float (&s)[8] = R.s;
    lds_barrier();
#pragma unroll
    for (int i = 0; i < 2; ++i) {
        const int idx = tid + 512 * i, row = idx >> 3, c8 = idx & 7;
        if (OUT) *(LAS u32x4*)(Qi + row * RS + c8 * 16) = rq[i];
        u32x4 kv = rk[i];
        if (!OUT) { float f[8]; unpack8(kv, f); const float sc = exp2f((float)(127 - row) * lg); kv.x = pkbf(f[0] * sc, f[1] * sc); kv.y = pkbf(f[2] * sc, f[3] * sc); kv.z = pkbf(f[4] * sc, f[5] * sc); kv.w = pkbf(f[6] * sc, f[7] * sc); }
        *(LAS u32x4*)(Ki + row * RS + c8 * 16) = kv;
        *(LAS u32x4*)(Vi + row * RS + c8 * 16) = rv[i];
    }
    if (OUT) {
        const int v = tid & 63, kg = tid >> 6;
        u32x4 o; o.x = pkbf(s[0], s[1]); o.y = pkbf(s[2], s[3]); o.z = pkbf(s[4], s[5]); o.w = pkbf(s[6], s[7]);
        *(LAS u32x4*)(Si + v * RS + kg * 16) = o;
    }
    if (hn) ret_load<OUT>(C, un >> 7, (un >> 2) & 31, un & 3, R);
    lds_barrier();
    const f32x4 z4 = {0.f, 0.f, 0.f, 0.f};
    if (!OUT) {
        const int kt = w >> 1, vt0 = (w & 1) * 2;
        f32x4 a0 = z4, a1 = z4;
#pragma unroll
        for (int jb = 0; jb < 4; ++jb) {
            const int j0 = 32 * jb + 8 * fq;
            const bf16x8 Af = trfrag(Ki, j0, j0 + 4, 16 * kt, fr);
            a0 = mfma16(Af, trfrag(Vi, j0, j0 + 4, 16 * vt0, fr), a0);
            a1 = mfma16(Af, trfrag(Vi, j0, j0 + 4, 16 * vt0 + 16, fr), a1);
        }
#pragma unroll
        for (int i = 0; i < 4; ++i) { Sg[(16 * kt + 4 * fq + i) * 64 + 16 * vt0 + fr] = a0[i]; Sg[(16 * kt + 4 * fq + i) * 64 + 16 * vt0 + 16 + fr] = a1[i]; }
        return;
    }
    const int t0 = 16 * w;
    float pgw[4], pgb[4];
#pragma unroll
    for (int vt = 0; vt < 4; ++vt) { pgw[vt] = C.PB[l * PB_N + PB_RGW + h * 64 + 16 * vt + fr]; pgb[vt] = C.PB[l * PB_N + PB_RGB + h * 64 + 16 * vt + fr]; }
    bf16 gq[4][4];
#pragma unroll
    for (int i = 0; i < 4; ++i)
#pragma unroll
        for (int vt = 0; vt < 4; ++vt) gq[i][vt] = C.PROJ[bm_idx((int)rowbase + t0 + 4 * fq + i, 1792 + h * 64 + 16 * vt + fr)];
    const bf16x8 Qf0 = ldsfrag(Qi + (t0 + fr) * RS + 16 * fq), Qf1 = ldsfrag(Qi + (t0 + fr) * RS + 16 * fq + 64);
    f32x4 O[4] = {z4, z4, z4, z4};
    for (int jb = 0; jb <= (w >> 1); ++jb) {
        f32x4 s0 = mfma16(ldsfrag(Ki + (32 * jb + fr) * RS + 16 * fq), Qf0, z4);
        s0 = mfma16(ldsfrag(Ki + (32 * jb + fr) * RS + 16 * fq + 64), Qf1, s0);
        f32x4 s1 = z4;
        if (2 * jb + 1 <= w) { s1 = mfma16(ldsfrag(Ki + (32 * jb + 16 + fr) * RS + 16 * fq), Qf0, z4); s1 = mfma16(ldsfrag(Ki + (32 * jb + 16 + fr) * RS + 16 * fq + 64), Qf1, s1); }
#pragma unroll
        for (int i = 0; i < 4; ++i) {
            const int d0 = (t0 + fr) - (32 * jb + 4 * fq + i), d1 = d0 - 16;
            s0[i] = d0 >= 0 ? s0[i] * exp2f((float)d0 * lg) : 0.f;
            s1[i] = d1 >= 0 ? s1[i] * exp2f((float)d1 * lg) : 0.f;
        }
        const bf16x8 Pf = pack8(s0, s1);
#pragma unroll
        for (int vt = 0; vt < 4; ++vt) O[vt] = mfma16(Pf, trfrag(Vi, 32 * jb + 4 * fq, 32 * jb + 16 + 4 * fq, 16 * vt, fr), O[vt]);
    }
#pragma unroll
    for (int vt = 0; vt < 4; ++vt) {
        f32x4 oi = mfma16(Qf0, ldsfrag(Si + (16 * vt + fr) * RS + 16 * fq), z4);
        oi = mfma16(Qf1, ldsfrag(Si + (16 * vt + fr) * RS + 16 * fq + 64), oi);
#pragma unroll
        for (int i = 0; i < 4; ++i) O[vt][i] = 0.125f * (O[vt][i] + exp2f((float)(t0 + 4 * fq + i + 1) * lg) * oi[i]);
    }
    bf16* Y = (bf16*)(C.ws + WS_Y);
#pragma unroll
    for (int i = 0; i < 4; ++i) {
        const float mu = sum16((O[0][i] + O[1][i]) + (O[2][i] + O[3][i])) * (1.f / 64.f);
        float q = 0.f;
#pragma unroll
        for (int vt = 0; vt < 4; ++vt) { const float d = O[vt][i] - mu; q += d * d; }
        const float rstd = 1.0f / sqrtf(sum16(q) * (1.f / 64.f) + EPS);
        const size_t row = rowbase + t0 + 4 * fq + i;
#pragma unroll
        for (int vt = 0; vt < 4; ++vt) {
            const int ch = h * 64 + 16 * vt + fr;
            const float g = bf2f(gq[i][vt]);
            const float y = ((O[vt][i] - mu) * rstd * pgw[vt] + pgb[vt]) * (g * sigmoidf_(g));
            Y[row * DM + 256 + ch] = (bf16)f2bf(y);
        }
    }
}

__device__ __forceinline__ void swa_unit_mfma(const Ctx& C, int l, int hb, int bl, int blk, int kvh) {
    LAS unsigned char* Ki = C.lds;
    LAS unsigned char* Vi = Ki + 256 * RS;
    const int tid = C.tid, lane = C.lane, w = C.wave, fr = lane & 15, fq = lane >> 4;
    u32x4 qraw[2][2];
#pragma unroll
    for (int tt = 0; tt < 2; ++tt) { const bf16* src = C.PROJ + bm_idx(bl * SEQ + blk * SEGL + 16 * ((w & 3) * 2 + tt) + fr, 2048 + (kvh * 2 + (w >> 2)) * 64 + 8 * fq);
        qraw[tt][0] = *(const u32x4*)src; qraw[tt][1] = *(const u32x4*)(src + 32); }
    u32x4 rk[4], rv[4];
#pragma unroll
    for (int i = 0; i < 4; ++i) {
        const int idx = tid + 512 * i, row = idx >> 3, c8 = idx & 7, pos = (blk - 1) * SEGL + row;
        const int pc = pos > 0 ? pos : 0;
        rk[i] = *(const u32x4*)(C.PROJ + bm_idx(bl * SEQ + pc, 2304 + kvh * 64 + 8 * c8)); rv[i] = *(const u32x4*)(C.PROJ + bm_idx(bl * SEQ + pc, 2432 + kvh * 64 + 8 * c8));
    }
    const f32x4 kw0 = *(const f32x4*)(C.PB + l * PB_N + PB_KN + 8 * (tid & 7)), kw1 = *(const f32x4*)(C.PB + l * PB_N + PB_KN + 8 * (tid & 7) + 4);
    const float* qn = C.PB + l * PB_N + PB_QN + 8 * fq;
    const f32x4 qw0 = *(const f32x4*)qn, qw1 = *(const f32x4*)(qn + 4), qw2 = *(const f32x4*)(qn + 32), qw3 = *(const f32x4*)(qn + 36);
    const float sink = C.PB[l * PB_N + PB_SINK + kvh * 2 + (w >> 2)];
    lds_barrier();
#pragma unroll
    for (int i = 0; i < 4; ++i) {
        const int idx = tid + 512 * i, row = idx >> 3, c8 = idx & 7;
        const bool zero = (blk - 1) * SEGL + row < 0;
        const u32x4 kv = zero ? (u32x4){0u, 0u, 0u, 0u} : rk[i], vv = zero ? (u32x4){0u, 0u, 0u, 0u} : rv[i];
        float f[8]; unpack8(kv, f);
        float ss = 0.f;
#pragma unroll
        for (int e = 0; e < 8; ++e) ss += f[e] * f[e];
        ss += swz_xor<1>(ss); ss += swz_xor<2>(ss); ss += swz_xor<4>(ss);
        const float r = 1.0f / sqrtf(ss * (1.f / 64.f) + EPS);
        const f32x4 w0 = kw0, w1 = kw1;
        u32x4 ko; ko.x = pkbf(f[0] * r * w0[0], f[1] * r * w0[1]); ko.y = pkbf(f[2] * r * w0[2], f[3] * r * w0[3]); ko.z = pkbf(f[4] * r * w1[0], f[5] * r * w1[1]); ko.w = pkbf(f[6] * r * w1[2], f[7] * r * w1[3]);
        *(LAS u32x4*)(Ki + row * RS + c8 * 16) = ko;
        *(LAS u32x4*)(Vi + row * RS + c8 * 16) = vv;
    }
    lds_barrier();
    const int g = w >> 2, h = kvh * 2 + g;
    const float slope = exp2f(-2.0f * (float)(h + 1));
    const f32x4 z4 = {0.f, 0.f, 0.f, 0.f};
    bf16* Y = (bf16*)(C.ws + WS_Y);
#pragma unroll 1
    for (int tt = 0; tt < 2; ++tt) {
        const int t0 = 16 * ((w & 3) * 2 + tt);
        const size_t qrow = (size_t)(bl * SEQ + blk * SEGL + t0);
        bf16x8 Qf0, Qf1;
        {
            float a[8], b[8]; unpack8(tt ? qraw[1][0] : qraw[0][0], a); unpack8(tt ? qraw[1][1] : qraw[0][1], b);
            float ss = 0.f;
#pragma unroll
            for (int e = 0; e < 8; ++e) ss += a[e] * a[e] + b[e] * b[e];
            ss = sum4g(ss, lane);
            const float r = 0.125f / sqrtf(ss * (1.f / 64.f) + EPS);
            const f32x4 w0 = qw0, w1 = qw1, w2 = qw2, w3 = qw3;
            u32x4 p; p.x = pkbf(a[0] * r * w0[0], a[1] * r * w0[1]); p.y = pkbf(a[2] * r * w0[2], a[3] * r * w0[3]); p.z = pkbf(a[4] * r * w1[0], a[5] * r * w1[1]); p.w = pkbf(a[6] * r * w1[2], a[7] * r * w1[3]);
            Qf0 = __builtin_bit_cast(bf16x8, p);
            p.x = pkbf(b[0] * r * w2[0], b[1] * r * w2[1]); p.y = pkbf(b[2] * r * w2[2], b[3] * r * w2[3]); p.z = pkbf(b[4] * r * w3[0], b[5] * r * w3[1]); p.w = pkbf(b[6] * r * w3[2], b[7] * r * w3[3]);
            Qf1 = __builtin_bit_cast(bf16x8, p);
        }
        const int jb0 = t0 >> 5;
        f32x4 s[10];
#pragma unroll
        for (int u = 0; u < 10; ++u) {
            const int jr = 32 * jb0 + 16 * u + fr;
            s[u] = mfma16(ldsfrag(Ki + jr * RS + 16 * fq), Qf0, z4);
            s[u] = mfma16(ldsfrag(Ki + jr * RS + 16 * fq + 64), Qf1, s[u]);
        }
        float m = sink;
        const unsigned dmax = blk > 0 ? 128u : (unsigned)(t0 + fr + 1);
#pragma unroll
        for (int u = 0; u < 10; ++u) {
#pragma unroll
            for (int i = 0; i < 4; ++i) {
                const int jl = 32 * jb0 + 16 * u + 4 * fq + i, dist = t0 + fr + 128 - jl;
                s[u][i] = (unsigned)dist < dmax ? s[u][i] - slope * (float)dist : -1e30f;
                m = fmaxf(m, s[u][i]);
            }
            __builtin_amdgcn_sched_barrier(0);
        }
        m = max4g(m, lane);
        float ls = 0.f;
#pragma unroll
        for (int u = 0; u < 10; ++u)
#pragma unroll
            for (int i = 0; i < 4; ++i) { const float p = __expf(s[u][i] - m); s[u][i] = p; ls += p; }
        ls = sum4g(ls, lane) + __expf(sink - m);
        const float inv = 1.0f / ls;
        f32x4 O[4] = {z4, z4, z4, z4};
#pragma unroll
        for (int jb = 0; jb < 5; ++jb) {
            const bf16x8 Pf = pack8(s[2 * jb] * inv, s[2 * jb + 1] * inv);
            const int j0 = 32 * (jb0 + jb) + 4 * fq;
#pragma unroll
            for (int vt = 0; vt < 4; ++vt) O[vt] = mfma16(Pf, trfrag(Vi, j0, j0 + 16, 16 * vt, fr), O[vt]);
        }
#pragma unroll
        for (int i = 0; i < 4; ++i)
#pragma unroll
            for (int vt = 0; vt < 4; ++vt) Y[(qrow + 4 * fq + i) * DM + 512 + h * 64 + 16 * vt + fr] = (bf16)f2bf(O[vt][i]);
    }
}

__device__ __forceinline__ float gelu_tanh(float x) { const float y = 0.7978845608028654f * (x + 0.044715f * x * x * x); const float t = 1.0f - 2.0f * __builtin_amdgcn_rcpf(1.0f + __expf(2.0f * y)); return 0.5f * x * (1.0f + t); }


struct HgRegs { u32x4 rq[2], rv[2]; float sv[8]; bf16 zr[16]; };
template <bool OUT>
__device__ __forceinline__ void hgrn_load(const Ctx& C, int bl, int seg, int h, HgRegs& R) {
    int tid = C.tid; asm volatile("" : "+v"(tid)); const int lane = tid & 63, w = C.wave; const size_t rowbase = (size_t)(bl * SEQ + seg * SEGL);
    const float* Sg = C.SH + ((size_t)((bl * NSEG + seg) * 4 + h)) * 4096;
#pragma unroll
    for (int i = 0; i < 2; ++i) {
        const int idx = tid + 512 * i, row = idx >> 3, c8 = idx & 7, prow = (int)rowbase + row;
        if (OUT) R.rq[i] = *(const u32x4*)(C.PROJ + bm_idx(prow, h * 64 + 8 * c8));
        R.rv[i] = *(const u32x4*)(C.PROJ + bm_idx(prow, 512 + h * 64 + 8 * c8));
    }
    if (OUT) {
#pragma unroll
        for (int e = 0; e < 8; ++e) R.sv[e] = Sg[(8 * (tid >> 6) + e) * 64 + (tid & 63)];
    }
    { const bf16* zs = C.PROJ + bm_idx((int)rowbase + 16 * w, 256 + h * 64 + lane);
#pragma unroll
      for (int t = 0; t < 16; ++t) R.zr[t] = zs[t * 64]; }
}
template <bool OUT>
__device__ __forceinline__ void hgrn_unit_mfma(const Ctx& C, int l, int hb, int bl, int seg, int h, HgRegs& R, bool hn, int un) {
    LAS unsigned char* Qi = C.lds;
    LAS unsigned char* Ki = Qi + 128 * RS;
    LAS unsigned char* Vi = Ki + 128 * RS;
    LAS float* BL = (LAS float*)(Vi + 128 * RS);
    LAS float* BO = BL + 128 * 68;
    LAS float* TT = BO + 512;
    LAS unsigned char* Si = (LAS unsigned char*)(TT + 512);
    const int tid = C.tid, lane = C.lane, w = C.wave, fr = lane & 15, fq = lane >> 4;
    const size_t rowbase = (size_t)(bl * SEQ + seg * SEGL);
    const float* PBL = C.PB + l * PB_N;
    float* Sg = C.SH + ((size_t)((bl * NSEG + seg) * 4 + h)) * 4096;
    u32x4 (&rq)[2] = R.rq; u32x4 (&rv)[2] = R.rv; float (&sv)[8] = R.sv;
    bf16 zr[16];
#pragma unroll
    for (int t = 0; t < 16; ++t) zr[t] = R.zr[t];
    const float lb = PBL[PB_LB + h * 64 + lane];
    lds_barrier();
#pragma unroll
    for (int i = 0; i < 2; ++i) {
        const int idx = tid + 512 * i, row = idx >> 3, c8 = idx & 7;
        if (OUT) *(LAS u32x4*)(Qi + row * RS + c8 * 16) = rq[i];
        *(LAS u32x4*)(Vi + row * RS + c8 * 16) = rv[i];
    }
    if (OUT) {
        const int v = tid & 63, kg = tid >> 6;
        u32x4 o; o.x = pkbf(sv[0], sv[1]); o.y = pkbf(sv[2], sv[3]); o.z = pkbf(sv[4], sv[5]); o.w = pkbf(sv[6], sv[7]);
        *(LAS u32x4*)(Si + v * RS + kg * 16) = o;
    }
    float kkv[16];
    {
        float cum = 0.f;
#pragma unroll
        for (int t = 0; t < 16; ++t) {
            const float sg = sigmoidf_(bf2f(zr[t])), f = fmaxf(lb, 1e-30f) + (1.f - lb) * sg;
            kkv[t] = (1.f - lb) * (1.f - sg);
            cum += __logf(f);
            BL[(16 * w + t) * 68 + lane] = cum;
            if (OUT) *(LAS bf16*)(Ki + (16 * w + t) * RS + 2 * lane) = (bf16)f2bf(kkv[t]);
        }
        TT[w * 64 + lane] = cum;
    }
    if (hn) hgrn_load<OUT>(C, un >> 7, (un >> 2) & 31, un & 3, R);
    lds_barrier();
    {   float bo = 0.f;
        for (int c = 0; c < w; ++c) bo += TT[c * 64 + lane];
        BO[w * 64 + lane] = bo;
        if (!OUT) {
            float tot = bo;
            for (int c = w; c < 8; ++c) tot += TT[c * 64 + lane];
#pragma unroll
            for (int t = 0; t < 16; ++t) *(LAS bf16*)(Ki + (16 * w + t) * RS + 2 * lane) = (bf16)f2bf(kkv[t] * __expf(tot - bo - BL[(16 * w + t) * 68 + lane]));
            if (w == 0) C.DH[((bl * NSEG + seg) * 4 + h) * 64 + lane] = __expf(tot);
        }
    }
    lds_barrier();
    const f32x4 z4 = {0.f, 0.f, 0.f, 0.f};
    if (!OUT) {
        const int kt = w >> 1, vt0 = (w & 1) * 2;
        f32x4 a0 = z4, a1 = z4;
#pragma unroll
        for (int jb = 0; jb < 4; ++jb) {
            const int j0 = 32 * jb + 8 * fq;
            const bf16x8 Af = trfrag(Ki, j0, j0 + 4, 16 * kt, fr);
            a0 = mfma16(Af, trfrag(Vi, j0, j0 + 4, 16 * vt0, fr), a0);
            a1 = mfma16(Af, trfrag(Vi, j0, j0 + 4, 16 * vt0 + 16, fr), a1);
        }
#pragma unroll
        for (int i = 0; i < 4; ++i) { Sg[(16 * kt + 4 * fq + i) * 64 + 16 * vt0 + fr] = a0[i]; Sg[(16 * kt + 4 * fq + i) * 64 + 16 * vt0 + 16 + fr] = a1[i]; }
        return;
    }
    const int c = w, t0 = 16 * c;
    float pow_[4];
#pragma unroll
    for (int vt = 0; vt < 4; ++vt) pow_[vt] = PBL[PB_HGN + h * 64 + 16 * vt + fr];
    bf16 gq[4][4];
#pragma unroll
    for (int i = 0; i < 4; ++i)
#pragma unroll
        for (int vt = 0; vt < 4; ++vt) gq[i][vt] = C.PROJ[bm_idx((int)rowbase + t0 + 4 * fq + i, 768 + h * 64 + 16 * vt + fr)];
    bf16x8 Qc[2], Qt[2], Qs[2];
    f32x4 bref[2][2], boc[2][2];
#pragma unroll
    for (int ks = 0; ks < 2; ++ks) {
        const int kx = 8 * fq + 32 * ks;
        float q[8]; unpack8(*(const LAS u32x4*)(Qi + (t0 + fr) * RS + 2 * kx), q);
        const f32x4 b0 = *(const LAS f32x4*)(BL + (t0 + fr) * 68 + kx), b1 = *(const LAS f32x4*)(BL + (t0 + fr) * 68 + kx + 4);
        bref[ks][0] = *(const LAS f32x4*)(BL + (t0 + 8) * 68 + kx); bref[ks][1] = *(const LAS f32x4*)(BL + (t0 + 8) * 68 + kx + 4);
        boc[ks][0] = *(const LAS f32x4*)(BO + c * 64 + kx); boc[ks][1] = *(const LAS f32x4*)(BO + c * 64 + kx + 4);
        f32x4 lo, hi;
#pragma unroll
        for (int e = 0; e < 4; ++e) { lo[e] = q[e] * __expf(b0[e]); hi[e] = q[4 + e] * __expf(b1[e]); }
        Qc[ks] = pack8(lo, hi);
#pragma unroll
        for (int e = 0; e < 4; ++e) { lo[e] = q[e] * __expf(b0[e] - bref[ks][0][e]); hi[e] = q[4 + e] * __expf(b1[e] - bref[ks][1][e]); }
        Qt[ks] = pack8(lo, hi);
#pragma unroll
        for (int e = 0; e < 4; ++e) { lo[e] = q[e] * __expf(boc[ks][0][e] + b0[e]); hi[e] = q[4 + e] * __expf(boc[ks][1][e] + b1[e]); }
        Qs[ks] = pack8(lo, hi);
    }
    f32x4 O[4] = {z4, z4, z4, z4};
    for (int jb = 0; jb <= (c >> 1); ++jb) {
        f32x4 st[2];
#pragma unroll
        for (int hf = 0; hf < 2; ++hf) {
            const int u = 2 * jb + hf;
            st[hf] = z4;
            if (u <= c) {
                const bool diag = (u == c);
#pragma unroll
                for (int ks = 0; ks < 2; ++ks) {
                    const int kx = 8 * fq + 32 * ks;
                    float k8[8]; unpack8(*(const LAS u32x4*)(Ki + (16 * u + fr) * RS + 2 * kx), k8);
                    const f32x4 b0 = *(const LAS f32x4*)(BL + (16 * u + fr) * 68 + kx), b1 = *(const LAS f32x4*)(BL + (16 * u + fr) * 68 + kx + 4);
                    f32x4 e0, e1;
                    if (diag) { e0 = bref[ks][0] - b0; e1 = bref[ks][1] - b1; }
                    else { e0 = boc[ks][0] - *(const LAS f32x4*)(BO + u * 64 + kx) - b0; e1 = boc[ks][1] - *(const LAS f32x4*)(BO + u * 64 + kx + 4) - b1; }
                    f32x4 lo, hi;
#pragma unroll
                    for (int e = 0; e < 4; ++e) { lo[e] = k8[e] * __expf(e0[e]); hi[e] = k8[4 + e] * __expf(e1[e]); }
                    st[hf] = mfma16(pack8(lo, hi), diag ? Qt[ks] : Qc[ks], st[hf]);
                }
                if (diag) {
#pragma unroll
                    for (int i = 0; i < 4; ++i) st[hf][i] = (4 * fq + i <= fr) ? st[hf][i] : 0.f;
                }
            }
        }
        const bf16x8 Pf = pack8(st[0], st[1]);
#pragma unroll
        for (int vt = 0; vt < 4; ++vt) O[vt] = mfma16(Pf, trfrag(Vi, 32 * jb + 4 * fq, 32 * jb + 16 + 4 * fq, 16 * vt, fr), O[vt]);
    }
#pragma unroll
    for (int vt = 0; vt < 4; ++vt) {
        O[vt] = mfma16(Qs[0], ldsfrag(Si + (16 * vt + fr) * RS + 16 * fq), O[vt]);
        O[vt] = mfma16(Qs[1], ldsfrag(Si + (16 * vt + fr) * RS + 16 * fq + 64), O[vt]);
    }
    bf16* Y = (bf16*)(C.ws + WS_Y);
    int fqe = fq; asm volatile("" : "+v"(fqe));
#pragma unroll
    for (int i = 0; i < 4; ++i) {
        const float ms = sum16((O[0][i] * O[0][i] + O[1][i] * O[1][i]) + (O[2][i] * O[2][i] + O[3][i] * O[3][i])) * (1.f / 64.f);
        const float rstd = 1.0f / sqrtf(ms + EPS);
        const size_t row = rowbase + t0 + 4 * fqe + i;
#pragma unroll
        for (int vt = 0; vt < 4; ++vt) {
            const int ch = h * 64 + 16 * vt + fr;
            const float g = bf2f(gq[i][vt]);
            Y[row * DM + ch] = (bf16)f2bf(O[vt][i] * rstd * pow_[vt] * sigmoidf_(g));
        }
    }
}

constexpr int LRU_PB_OFF = 114688;
struct LruRegs { u32x4 xr[3]; float gv[16]; };
__device__ __forceinline__ void lru_params_to_lds(const Ctx& C, int l, int n) {
    LAS unsigned char* P = C.lds + LRU_PB_OFF; LAS float* PF = (LAS float*)(P + 2 * 64 * RS);
    const bf16* WT = C.W + (size_t)l * E_LAYER + O_WLRU;
    const float* PBL = C.PB + l * PB_N;
    lds_barrier();
    for (int idx = C.tid; idx < 2 * 64 * 8; idx += 512) { const int gate = idx >> 9, e = (idx >> 3) & 63, c8 = idx & 7;
        *(LAS u32x4*)(P + (gate * 64 + e) * RS + c8 * 16) = *(const u32x4*)(WT + ((size_t)(gate * 4 + n) * 64 + e) * 64 + 8 * c8); }
    if (C.tid < 256) PF[C.tid] = PBL[PB_CW + (C.tid >> 6) * 256 + n * 64 + (C.tid & 63)];
    else { const int k = (C.tid - 256) >> 6, c = C.tid & 63; PF[256 + k * 64 + c] = PBL[(k == 0 ? PB_CB : k == 1 ? PB_BA : k == 2 ? PB_BX : PB_SP) + n * 64 + c]; }
    lds_barrier();
}
template <bool OUT>
__device__ __forceinline__ void lru_load(const Ctx& C, int bl, int seg, int n, LruRegs& R) {
    int tid = C.tid; asm volatile("" : "+v"(tid)); const int lane = tid & 63, w = C.wave; const size_t rowbase = (size_t)(bl * SEQ + seg * SEGL);
    if (OUT) { const bf16* gp = C.PROJ + bm_idx((int)rowbase + 16 * w, 2816 + n * 64 + lane);
#pragma unroll
        for (int t = 0; t < 16; ++t) R.gv[t] = bf2f(gp[t * 64]); }
#pragma unroll
    for (int i = 0; i < 3; ++i) { const int idx = tid + 512 * i, r = (idx >> 3) < 130 ? (idx >> 3) : 130, c8 = idx & 7, t_abs = seg * SEGL - 3 + r;
        R.xr[i] = *(const u32x4*)(C.PROJ + bm_idx(bl * SEQ + (t_abs > 0 ? t_abs : 0), 2560 + n * 64 + 8 * c8)); }
}
template <bool OUT>
__device__ __forceinline__ void lru_unit_mfma(const Ctx& C, int l, int hb, int bl, int seg, int n, LruRegs& R, bool hn, int un) {
    LAS unsigned char* Xi = C.lds;
    LAS unsigned char* XCi = Xi + 132 * RS;
    LAS float* A = (LAS float*)(XCi + 128 * RS);
    LAS float* U = A + 128 * 68;
    LAS float* PC = U + 128 * 68;
    LAS float* HC = PC + 512;
    const int tid = C.tid, lane = C.lane, w = C.wave, fr = lane & 15, fq = lane >> 4;
    const size_t rowbase = (size_t)(bl * SEQ + seg * SEGL);
    if (C.G & 3) lru_params_to_lds(C, l, n);
    const LAS unsigned char* PP = C.lds + LRU_PB_OFF; const LAS float* PF = (const LAS float*)(PP + 2 * 64 * RS);
    float gv[16];
#pragma unroll
    for (int t = 0; t < 16; ++t) gv[t] = OUT ? R.gv[t] : 0.f;
    u32x4 (&xr)[3] = R.xr;
    lds_barrier();
#pragma unroll
    for (int i = 0; i < 3; ++i) { const int idx = tid + 512 * i, r = idx >> 3, c8 = idx & 7; const bool zero = seg * SEGL - 3 + r < 0;
        if (idx < 131 * 8) *(LAS u32x4*)(Xi + r * RS + c8 * 16) = zero ? (u32x4){0u, 0u, 0u, 0u} : xr[i]; }
    if (hn) lru_load<OUT>(C, un >> 7, (un >> 2) & 31, un & 3, R);
    lds_barrier();
    {
        const int t = tid >> 2, c16 = (tid & 3) * 16;
        float acc[16];
#pragma unroll
        for (int e4 = 0; e4 < 4; ++e4) { const f32x4 b = *(const LAS f32x4*)(PF + 256 + c16 + 4 * e4); acc[4 * e4] = b[0]; acc[4 * e4 + 1] = b[1]; acc[4 * e4 + 2] = b[2]; acc[4 * e4 + 3] = b[3]; }
#pragma unroll
        for (int j = 0; j < 4; ++j) {
            float x[16]; unpack8(*(const LAS u32x4*)(Xi + (t + j) * RS + 2 * c16), x); unpack8(*(const LAS u32x4*)(Xi + (t + j) * RS + 2 * c16 + 16), x + 8);
#pragma unroll
            for (int e4 = 0; e4 < 4; ++e4) { const f32x4 wv = *(const LAS f32x4*)(PF + j * 64 + c16 + 4 * e4);
                acc[4 * e4] += wv[0] * x[4 * e4]; acc[4 * e4 + 1] += wv[1] * x[4 * e4 + 1]; acc[4 * e4 + 2] += wv[2] * x[4 * e4 + 2]; acc[4 * e4 + 3] += wv[3] * x[4 * e4 + 3]; }
        }
        u32x4 o0, o1; o0.x = pkbf(acc[0], acc[1]); o0.y = pkbf(acc[2], acc[3]); o0.z = pkbf(acc[4], acc[5]); o0.w = pkbf(acc[6], acc[7]);
        o1.x = pkbf(acc[8], acc[9]); o1.y = pkbf(acc[10], acc[11]); o1.z = pkbf(acc[12], acc[13]); o1.w = pkbf(acc[14], acc[15]);
        *(LAS u32x4*)(XCi + t * RS + 2 * c16) = o0; *(LAS u32x4*)(XCi + t * RS + 2 * c16 + 16) = o1;
    }
    lds_barrier();
    {
        const f32x4 z4 = {0.f, 0.f, 0.f, 0.f};
        const bf16x8 Xf0 = ldsfrag(XCi + (16 * w + fr) * RS + 16 * fq), Xf1 = ldsfrag(XCi + (16 * w + fr) * RS + 16 * fq + 64);
#pragma unroll
        for (int et = 0; et < 4; ++et) {
            const int e = 16 * et + fr;
            const LAS unsigned char* wa = PP + (0 * 64 + e) * RS + 16 * fq;
            const LAS unsigned char* wx = PP + (1 * 64 + e) * RS + 16 * fq;
            f32x4 ra = mfma16(Xf0, ldsfrag(wa), z4); ra = mfma16(Xf1, ldsfrag(wa + 64), ra);
            f32x4 ia = mfma16(Xf0, ldsfrag(wx), z4); ia = mfma16(Xf1, ldsfrag(wx + 64), ia);
            const float ba = PF[256 + 64 + e], bx = PF[256 + 128 + e], sp = PF[256 + 192 + e];
#pragma unroll
            for (int i = 0; i < 4; ++i) {
                const int t = 16 * w + 4 * fq + i;
                const float r = sigmoidf_(ra[i] + ba), ig = sigmoidf_(ia[i] + bx), xc = bf2f(*(const LAS bf16*)(XCi + t * RS + 2 * e));
                const float la = -8.0f * r * sp;
                A[t * 68 + e] = __expf(la);
                const float x2 = 2.0f * la;
                const float om = x2 > -0.25f ? -x2 * (1.0f + x2 * (0.5f + x2 * (0.16666667f + x2 * (0.041666668f + x2 * 0.0083333338f)))) : 1.0f - __expf(x2);
                U[t * 68 + e] = __builtin_amdgcn_sqrtf(om) * (ig * xc);
            }
        }
    }
    lds_barrier();
    {
        float P = 1.f, hl = 0.f;
#pragma unroll
        for (int t = 0; t < 16; ++t) { const float a = A[(16 * w + t) * 68 + lane], u = U[(16 * w + t) * 68 + lane]; hl = a * hl + u; P *= a; }
        PC[w * 64 + lane] = P; HC[w * 64 + lane] = hl;
    }
    lds_barrier();
    const int sidx = (bl * NSEG + seg) * 256 + n * 64 + lane;
    if (!OUT) {
        if (w == 0) { float hh = 0.f, P = 1.f;
#pragma unroll
            for (int c = 0; c < 8; ++c) { hh = PC[c * 64 + lane] * hh + HC[c * 64 + lane]; P *= PC[c * 64 + lane]; }
            C.HEND[sidx] = hh; C.PEND[sidx] = P; }
        return;
    }
    float hh = C.HEND[sidx];
    for (int c = 0; c < w; ++c) hh = PC[c * 64 + lane] * hh + HC[c * 64 + lane];
    bf16* Y = (bf16*)(C.ws + WS_Y);
#pragma unroll
    for (int t = 0; t < 16; ++t) {
        hh = A[(16 * w + t) * 68 + lane] * hh + U[(16 * w + t) * 68 + lane];
        Y[(rowbase + 16 * w + t) * DM + 768 + n * 64 + lane] = (bf16)f2bf(hh * gelu_tanh(gv[t]));
    }
}

__device__ __forceinline__ float wave_max(float v, int lane) {
    v = fmaxf(v, swz_xor<1>(v)); v = fmaxf(v, swz_xor<2>(v)); v = fmaxf(v, swz_xor<4>(v)); v = fmaxf(v, swz_xor<8>(v)); v = fmaxf(v, swz_xor<16>(v));
    return fmaxf(v, __int_as_float(__builtin_amdgcn_ds_bpermute((lane ^ 32) << 2, __float_as_int(v))));
}
__device__ __forceinline__ unsigned q4(float a, float b, float c, float d) {
    unsigned w = 0u;
    w = __builtin_amdgcn_cvt_pk_u8_f32(a + 128.0f, 0, w); w = __builtin_amdgcn_cvt_pk_u8_f32(b + 128.0f, 1, w); w = __builtin_amdgcn_cvt_pk_u8_f32(c + 128.0f, 2, w); w = __builtin_amdgcn_cvt_pk_u8_f32(d + 128.0f, 3, w);
    return w ^ 0x80808080u;
}
__device__ __forceinline__ void quant_rows(const Ctx& C, int l) {
    constexpr int NR = MT + NGATE, RPT = 6;
    const int gw = C.bid * 8 + C.wave, NGW = C.G * 8;
    const bf16* Wg = C.W + (size_t)l * E_LAYER + O_WIN + (size_t)NPROJ * DM;
    unsigned char* XQ = C.ws + WS_XQ; unsigned char* WQ = C.ws + WS_WQ; float* rowf = (float*)(C.ws + WS_ROWF); float* csc = (float*)(C.ws + WS_CSC);
#pragma unroll 1
    for (int m0 = gw; m0 < NR; m0 += RPT * NGW) {
        u32x4 v[RPT][2];
#pragma unroll
        for (int rr = 0; rr < RPT; ++rr) { int r = m0 + rr * NGW; r = r < NR ? r : NR - 1;
            const bf16* src = r < MT ? C.HN + (size_t)r * DM : Wg + (size_t)(r - MT) * DM;
            v[rr][0] = ((const u32x4*)src)[C.lane]; v[rr][1] = ((const u32x4*)src)[C.lane + 64]; }
#pragma unroll
        for (int rr = 0; rr < RPT; ++rr) { const int r = m0 + rr * NGW;
            if (r < NR) {
                float x[16]; unpack8(v[rr][0], x); unpack8(v[rr][1], x + 8);
                float a = 0.f, q = 0.f;
#pragma unroll
                for (int e = 0; e < 16; ++e) { a = fmaxf(a, fabsf(x[e])); q += x[e] * x[e]; }
                a = wave_max(a, C.lane); q = wave_sum(q, C.lane);
                const float inv = a > 0.f ? 127.0f / a : 0.f, s = a * (1.0f / 127.0f);
#pragma unroll
                for (int e = 0; e < 16; ++e) x[e] = rintf(x[e] * inv);
                unsigned char* dst = r < MT ? XQ + (size_t)r * DM : WQ + (size_t)(r - MT) * DM;
                ((u32x2*)dst)[C.lane] = (u32x2){q4(x[0], x[1], x[2], x[3]), q4(x[4], x[5], x[6], x[7])};
                ((u32x2*)dst)[C.lane + 64] = (u32x2){q4(x[8], x[9], x[10], x[11]), q4(x[12], x[13], x[14], x[15])};
                if (C.lane == 0) { if (r < MT) rowf[r] = s / sqrtf(q * (1.f / DM) + EPS); else csc[r - MT] = s; }
            }
        }
    }
}

#define UNIT_LOOP(Regs, loadf, unitf) { Regs R; int u = C.bid; if (u < BATCH * 128) loadf(C, u >> 7, (u >> 2) & 31, u & 3, R); \
    for (; u < BATCH * 128; u += C.G) { const int un = u + C.G; unitf(C, l, hb, u >> 7, (u >> 2) & 31, u & 3, R, un < BATCH * 128, un); } }
__device__ __forceinline__ void mix_local_phase(const Ctx& C, int l, int hb) {
    quant_rows(C, l);
    UNIT_LOOP(HgRegs, hgrn_load<false>, hgrn_unit_mfma<false>)
    UNIT_LOOP(RetRegs, ret_load<false>, ret_unit_mfma<false>)
    lru_params_to_lds(C, l, C.bid & 3);
    UNIT_LOOP(LruRegs, lru_load<false>, lru_unit_mfma<false>)
}
__device__ __forceinline__ void mix_scan_phase(const Ctx& C, int l, int hb) {
    for (int gi = C.bid * 512 + C.tid; gi < 2 * BH * 16384; gi += C.G * 512) {
        const int mixer = gi / (BH * 16384), e = gi % (BH * 16384), bl = e >> 14, hh = (e >> 12) & 3, kv = e & 4095, k = kv >> 6;
        float* S = (mixer == 0 ? C.SH : C.SR) + ((size_t)(bl * NSEG * 4 + hh)) * 4096 + kv;
        const float* D = C.DH + (bl * NSEG * 4 + hh) * 64 + k;
        float g128 = 1.0f - exp2f(-5.0f - (float)hh);
#pragma unroll
        for (int i = 0; i < 7; ++i) g128 *= g128;
        float sl[NSEG], dd[NSEG];
#pragma unroll
        for (int seg = 0; seg < NSEG; ++seg) { sl[seg] = S[(size_t)seg * 4 * 4096]; dd[seg] = mixer == 0 ? D[seg * 4 * 64] : g128; }
        float carry = 0.f;
#pragma unroll
        for (int seg = 0; seg < NSEG; ++seg) { S[(size_t)seg * 4 * 4096] = carry; carry = dd[seg] * carry + sl[seg]; }
    }
    for (int gi = C.bid * 512 + C.tid; gi < BH * 256; gi += C.G * 512) {
        const int bl = gi >> 8, c = gi & 255; float he[NSEG], pe[NSEG];
#pragma unroll
        for (int seg = 0; seg < NSEG; ++seg) { he[seg] = C.HEND[(bl * NSEG + seg) * 256 + c]; pe[seg] = C.PEND[(bl * NSEG + seg) * 256 + c]; }
        float carry = 0.f;
#pragma unroll
        for (int seg = 0; seg < NSEG; ++seg) { C.HEND[(bl * NSEG + seg) * 256 + c] = carry; carry = pe[seg] * carry + he[seg]; }
    }
    for (int u = C.bid; u < BATCH * 64; u += C.G) swa_unit_mfma(C, l, hb, u >> 6, (u >> 1) & 31, u & 1);
}
__device__ __forceinline__ void mix_out_phase(const Ctx& C, int l, int hb) {
    UNIT_LOOP(HgRegs, hgrn_load<true>, hgrn_unit_mfma<true>)
    UNIT_LOOP(RetRegs, ret_load<true>, ret_unit_mfma<true>)
    lru_params_to_lds(C, l, C.bid & 3);
    UNIT_LOOP(LruRegs, lru_load<true>, lru_unit_mfma<true>)
}

__global__ void __launch_bounds__(512, 2) fwd(Args args) {
    extern __shared__ __attribute__((aligned(16))) unsigned char lds_raw[];
    Ctx K;
    K.lds = (LAS unsigned char*)lds_raw;
    K.tid = 0; K.lane = 0; K.wave = __builtin_amdgcn_readfirstlane(threadIdx.x >> 6); K.G = gridDim.x; K.bid = blockIdx.x;
    K.in.t = (InTab)__builtin_amdgcn_kernarg_segment_ptr(); K.out = args.out; K.ws = args.ws;
    volatile LAS unsigned* MISC = (volatile LAS unsigned*)(K.lds + LDSCTL_OFF);
    if (threadIdx.x < 64) MISC[threadIdx.x] = 0u;
    __syncthreads();
    const int lo = args.ph_lo, hi = args.ph_hi;
    XcdBarrier bar; bar.bar = (unsigned*)(args.ws + WS_CTL) + CW_BAR; bar.x = 0; bar.st = MISC + 8; bar.wave = K.wave;
    if (hi - lo > 1) bar = xcd_barrier_post((unsigned*)(args.ws + WS_CTL) + CW_BAR, MISC + 8, K.wave);
    int ph = 0;
#define PH_BEGIN if (ph >= lo && ph < hi) { const Ctx C = phase_ctx(K);
#define PH_END   if (ph + 1 < hi) xcd_barrier(bar); } ++ph;

    PH_BEGIN
        LAS float* scr = (LAS float*)(C.lds + C.wave * 16384);
        const int gw = C.bid * 8 + C.wave, NGW = C.G * 8;
        {
            float ra[32], rb[32];
            int it = gw; ItemDesc da = decode_item(C, it < DEPTH * IT_LAYER ? it : 0), db = da;
            if (it < DEPTH * IT_LAYER) tr_load(da, ra, C.lane);
#pragma unroll 1
            while (it < DEPTH * IT_LAYER) {
                const int i1 = it + NGW, i2 = it + 2 * NGW;
                if (i1 < DEPTH * IT_LAYER) { db = decode_item(C, i1); tr_load(db, rb, C.lane); }
                tr_finish(da, ra, scr, C.lane);
                if (i1 >= DEPTH * IT_LAYER) break;
                if (i2 < DEPTH * IT_LAYER) { da = decode_item(C, i2); tr_load(da, ra, C.lane); }
                tr_finish(db, rb, scr, C.lane);
                it = i2;
            }
        }
        for (int e = C.bid * 512 + C.tid; e < DEPTH * PB_N; e += C.G * 512) {
            const int pl = e / PB_N, o = e % PB_N; float v = 0.f;
            if (o < 256) v = C.in[I_HGN][pl * 256 + o];
            else if (o < 512) v = C.in[I_RGW][pl * 256 + o - 256];
            else if (o < 768) v = C.in[I_RGB][pl * 256 + o - 512];
            else if (o < 832) v = C.in[I_QN][pl * 64 + o - 768];
            else if (o < 896) v = C.in[I_KN][pl * 64 + o - 832];
            else if (o < 900) v = C.in[I_SINK][pl * 4 + o - 896];
            else if (o < 1024) v = 0.f;
            else if (o < 2048) v = C.in[I_CW][pl * 1024 + o - 1024];
            else if (o < 2304) v = C.in[I_CB][pl * 256 + o - 2048];
            else if (o < 2560) v = C.in[I_BA][pl * 256 + o - 2304];
            else if (o < 2816) v = C.in[I_BX][pl * 256 + o - 2560];
            else if (o < 3072) v = log1pf(expf(-C.in[I_LAM][pl * 256 + o - 2816]));
            else if (o < 3328) v = hgrn_lb(C.in[I_LBL], pl, o - 3072);
            else if (o < 4096) v = 0.f;
            else v = C.in[I_GBIAS][pl * 4096 + o - 4096];
            C.PB[e] = v;
        }
        for (int e = C.bid * 512 + C.tid; e < DEPTH * (int)E_WLRU; e += C.G * 512) {
            const int pl = e / (int)E_WLRU, o = e % (int)E_WLRU, gate = o >> 14, n = (o >> 12) & 3, ee = (o >> 6) & 63, c = o & 63;
            const float v = (gate ? C.in[I_WX] : C.in[I_WA])[((size_t)(pl * 4 + n) * 64 + c) * 64 + ee];
            (C.W + (size_t)pl * E_LAYER + O_WLRU)[o] = (bf16)f2bf(v);
        }
        {
            float* ssq0 = (float*)(C.ws + WS_SSQ);
            for (int m = gw; m < MT; m += 4 * NGW) {
                f32x4 v[4][4];
#pragma unroll
                for (int rr = 0; rr < 4; ++rr)
#pragma unroll
                    for (int j = 0; j < 4; ++j) v[rr][j] = ((const f32x4*)(C.in[I_X] + (size_t)(m + rr * NGW) * DM) + C.lane)[64 * j];
#pragma unroll
                for (int rr = 0; rr < 4; ++rr) {
                    const int mm = m + rr * NGW; unsigned long long* o8 = (unsigned long long*)(C.HN + (size_t)mm * DM) + C.lane; float q = 0.f;
#pragma unroll
                    for (int j = 0; j < 4; ++j) { const f32x4 x = v[rr][j]; q += (x.x * x.x + x.y * x.y) + (x.z * x.z + x.w * x.w); o8[64 * j] = (unsigned long long)pk2(x.x, x.y) | ((unsigned long long)pk2(x.z, x.w) << 32); }
                    q = wave_sum(q, C.lane);
                    if (C.lane < 16) ssq0[(size_t)mm * 16 + C.lane] = C.lane == 0 ? q : 0.f;
                }
            }
        }
    PH_END

#pragma unroll 1
    for (int l = 0; l < DEPTH; ++l) {
#pragma unroll 1
        for (int f = 0; f < 2; ++f) {
            PH_BEGIN
#ifndef NO_UP
                pg8::Gemm g{DM, DM, DM}; pg8::StaticOrder S; S.init(MT, NGU, C.G, C.bid, C.HN, DM, C.W + (size_t)l * E_LAYER + (f == 0 ? O_WGU1 : O_WGU2), DM);
                pg8::EpiSwiglu E{C.ws, (unsigned)((l * 3 + (f == 0 ? 0 : 2)) * MT)};
                pg8::gemm_phase<pg8::EpiSwiglu, pg8::StaticOrder, true>(C.lds, C.tid, g, S, E);
#endif
            PH_END
            PH_BEGIN
#ifndef NO_DOWN
                pg8::Gemm g{DFF, DFF, DFF}; pg8::StaticOrder S; S.init(MT, DM, C.G, C.bid, C.HID, DFF, C.W + (size_t)l * E_LAYER + (f == 0 ? O_WD1 : O_WD2), DFF);
                const bool feeds = (f == 0) || (l + 1 < DEPTH);
                pg8::EpiResid E{C.out, 0.5f, C.ws, 0u, (unsigned)((f == 0 ? l * 3 + 1 : (feeds ? (l + 1) * 3 : 0)) * MT), feeds, !feeds};
                pg8::gemm_phase<pg8::EpiResid, pg8::StaticOrder, true>(C.lds, C.tid, g, S, E);
#endif
            PH_END
            if (f == 0) {
                const int hb = 0;
                PH_BEGIN
#ifndef NO_WIN
                    pg8::Gemm g{DM, DM, DM}; pg8::StaticOrder S; S.init(MT, NPROJ, C.G, C.bid, C.HN, DM, C.W + (size_t)l * E_LAYER + O_WIN, DM);
                    pg8::EpiWin E{C.ws, (unsigned)(l * PB_N + PB_GB), (unsigned)((l * 3 + 1) * MT), false};
                    pg8::gemm_phase<pg8::EpiWin, pg8::StaticOrder, true>(C.lds, C.tid, g, S, E);
#endif
                PH_END
                PH_BEGIN
                    mix_local_phase(C, l, hb);
                PH_END
                PH_BEGIN
                    mix_scan_phase(C, l, hb);
                PH_END
                PH_BEGIN
                    mix_out_phase(C, l, hb);
                PH_END
                PH_BEGIN
#ifndef NO_WIN
                    pg8::Gemm g{DM / 2, DM / 2, DM / 2}; pg8::StaticOrder S; S.init(MT, NGATE, C.G, C.bid, C.ws + WS_XQ, DM / 2, C.ws + WS_WQ, DM / 2);
                    pg8::EpiGate8 E{C.ws, (unsigned)(l * PB_N + PB_GB)};
                    pg8::gemm_phase<pg8::EpiGate8, pg8::StaticOrder, true>(C.lds, C.tid, g, S, E);
#endif
                PH_END
                PH_BEGIN
#ifndef NO_MERGE
                    pg8::Gemm g{DM, DM, DM}; pg8::MergeOrder S; S.init(MT, C.G, C.bid, C.ws + WS_Y, C.W + (size_t)l * E_LAYER + O_WB);
                    pg8::EpiMerge E{C.ws};
                    pg8::gemm_phase<pg8::EpiMerge, pg8::MergeOrder, true, true>(C.lds, C.tid, g, S, E);
#endif
                PH_END
                PH_BEGIN
#ifndef NO_WOUT
                    pg8::Gemm g{DM, DM, DM}; pg8::StaticOrder S; S.init(MT, DM, C.G, C.bid, C.MERGED, DM, C.W + (size_t)l * E_LAYER + O_WOUT, DM);
                    pg8::EpiResid E{C.out, 1.0f, C.ws, 0u, (unsigned)((l * 3 + 2) * MT), true, false};
                    pg8::gemm_phase<pg8::EpiResid, pg8::StaticOrder, true>(C.lds, C.tid, g, S, E);
#endif
                PH_END
            }
        }
    }
#undef PH_BEGIN
#undef PH_END
}
constexpr int N_PHASES = 1 + DEPTH * (2 + 7 + 2);

extern "C" void kernel_launch(void* const* d_in, const int* in_sizes, int n_in, void* d_out, int out_size, void* d_ws, size_t ws_size, hipStream_t stream) {
    static int grid = 0;
    if (grid == 0) {
        if (n_in != 28 || in_sizes[0] != MT * DM || out_size != MT * DM || ws_size < WS_END3) { fprintf(stderr, "kernel_launch: unexpected shapes (n_in %d, x %d, out %d, ws %zu < %zu); nothing launched\n", n_in, n_in > 0 ? in_sizes[0] : -1, out_size, ws_size, (size_t)WS_END3); grid = -1; return; }
        int dev = 0, cus = 0, per_cu = 0;
        if (hipGetDevice(&dev) != hipSuccess || hipDeviceGetAttribute(&cus, hipDeviceAttributeMultiprocessorCount, dev) != hipSuccess) { grid = -1; return; }
        if (hipFuncSetAttribute((const void*)fwd, hipFuncAttributeMaxDynamicSharedMemorySize, LDS_BYTES) != hipSuccess) { fprintf(stderr, "kernel_launch: hipFuncSetAttribute failed\n"); grid = -1; return; }
        if (hipOccupancyMaxActiveBlocksPerMultiprocessor(&per_cu, (const void*)fwd, 512, LDS_BYTES) != hipSuccess || per_cu < 1) fprintf(stderr, "kernel_launch: occupancy query reports %d\n", per_cu);
        (void)hipGetLastError();
        grid = cus;
    }
    if (grid < 0) return;
    (void)hipMemsetAsync((char*)d_ws + WS_CTL, 0, CTL_ZERO_BYTES, stream);
    Args a{};
    for (int i = 0; i < 28; ++i) a.in[i] = (const float*)d_in[i];
    a.out = (float*)d_out; a.ws = (unsigned char*)d_ws;
#if MK_MULTI
    for (int p = 0; p < N_PHASES; ++p) { a.ph_lo = p; a.ph_hi = p + 1; hipLaunchKernelGGL(fwd, dim3(grid), dim3(512), LDS_BYTES, stream, a); }
#else
    a.ph_lo = 0; a.ph_hi = N_PHASES;
    hipLaunchKernelGGL(fwd, dim3(grid), dim3(512), LDS_BYTES, stream, a);
#endif
}
```

```cpp
#include <hip/hip_runtime.h>
#include <cstdio>
#include <cstdint>

#ifndef MK_MULTI
#define MK_MULTI 0
#endif

#define LAS __attribute__((address_space(3)))
#define GAS __attribute__((address_space(1)))
typedef unsigned short bf16;
typedef short bf16x8 __attribute__((ext_vector_type(8)));
typedef float f32x4 __attribute__((ext_vector_type(4)));
typedef float f32x2 __attribute__((ext_vector_type(2)));
typedef unsigned u32x4 __attribute__((ext_vector_type(4)));
typedef unsigned u32x2 __attribute__((ext_vector_type(2)));
typedef int i32x4 __attribute__((ext_vector_type(4)));

constexpr int DM = 1024, BATCH = 8, SEQ = 4096, DEPTH = 2, DFF = 2816, DIN = 7168, NPROJ = 3072, NGATE = 4096;
constexpr int MT = BATCH * SEQ;
constexpr int MH = MT;
constexpr int BH = BATCH;
constexpr int NSEG = 32, SEGL = 128;
constexpr int NGU = 2 * DFF;
constexpr float EPS = 1e-6f;

constexpr size_t MiB = 1u << 20;
constexpr size_t WS_CTL = 0, CTL_ZERO_BYTES = 32 * 1024;
constexpr size_t E_WGU = (size_t)NGU * DM, E_WD = (size_t)DM * DFF, E_WIN = (size_t)DIN * DM, E_WB = (size_t)4 * DM * 256, E_WOUT = (size_t)DM * DM;
constexpr size_t O_WGU1 = 0, O_WD1 = O_WGU1 + E_WGU, O_WIN = O_WD1 + E_WD, O_WB = O_WIN + E_WIN, O_WOUT = O_WB + E_WB, O_WGU2 = O_WOUT + E_WOUT, O_WD2 = O_WGU2 + E_WGU;
constexpr size_t O_WLRU = O_WD2 + E_WD, E_WLRU = 2 * 4 * 64 * 64;
constexpr size_t E_LAYER = O_WLRU + E_WLRU;
constexpr size_t WS_W = 2 * MiB;
constexpr size_t WS_PB = 104 * MiB + 512 * 1024;
constexpr int PB_N = 8192, PB_HGN = 0, PB_RGW = 256, PB_RGB = 512, PB_QN = 768, PB_KN = 832, PB_SINK = 896, PB_CW = 1024, PB_CB = 2048, PB_BA = 2304, PB_BX = 2560, PB_SP = 2816, PB_LB = 3072, PB_GB = 4096;
constexpr size_t WS_HN = 105 * MiB;
constexpr size_t WS_U = 169 * MiB;
constexpr size_t WS_HID = WS_U;
constexpr size_t WS_PROJ = WS_U;
constexpr size_t WS_GATES = WS_U;
constexpr size_t WS_MERGED = WS_U + 128 * MiB;
constexpr size_t WS_SH = WS_U + 192 * MiB;
constexpr size_t WS_SR = WS_U + 208 * MiB;
constexpr size_t WS_Y = WS_U + 224 * MiB;
constexpr size_t WS_DH = WS_U + 288 * MiB;
constexpr size_t WS_HEND = WS_DH + 256 * 1024;
constexpr size_t WS_PEND = WS_HEND + 256 * 1024;
constexpr size_t WS_END = WS_U + 289 * MiB;
static_assert(WS_W + 2 * E_LAYER * 2 <= WS_PB && WS_PB + DEPTH * PB_N * 4 <= WS_HN && WS_HN + (size_t)MT * DM * 2 <= WS_U && WS_HID + (size_t)MT * DFF * 2 <= WS_END, "ws map");
static_assert(WS_PROJ + (size_t)MT * NPROJ * 2 <= WS_SH && WS_GATES + (size_t)MT * NGATE <= WS_MERGED && WS_MERGED + (size_t)MT * DM * 2 <= WS_SH, "mixer-stage overlays");
constexpr int CW_BAR = 4096;
static_assert((CW_BAR + 3456) * 4 <= (int)CTL_ZERO_BYTES, "barrier words inside the per-call memset");
constexpr size_t WS_SSQ = WS_END;
constexpr size_t WS_END2 = WS_SSQ + (size_t)3 * DEPTH * MT * 16 * 4;
constexpr size_t WS_XQ = WS_END2;
constexpr size_t WS_ROWF = WS_XQ + (size_t)MT * DM;
constexpr int QW_L = 2 * NGU + NGATE, QW_GU1 = 0, QW_G = NGU, QW_GU2 = NGU + NGATE;
constexpr size_t WS_CSC = WS_ROWF + (size_t)MT * 4;
constexpr size_t WS_END3 = WS_CSC + (size_t)DEPTH * QW_L * 4;
constexpr int RING_BYTES = 131072;
constexpr int LDSCTL_OFF = 143360;
constexpr int LDS_BYTES = 147456;

__device__ __forceinline__ int lane_id() { int l; asm volatile("v_mbcnt_lo_u32_b32 %0, -1, 0\n\tv_mbcnt_hi_u32_b32 %0, -1, %0" : "=v"(l)); return l; }
__device__ __forceinline__ float bf2f(unsigned h) { return __uint_as_float(h << 16); }
__device__ __forceinline__ unsigned f2bf(float f) { unsigned u = __float_as_uint(f); return (u + 0x7fffu + ((u >> 16) & 1u)) >> 16; }
__device__ __forceinline__ unsigned pk2(float lo, float hi) { return f2bf(lo) | (f2bf(hi) << 16); }
__device__ __forceinline__ unsigned cvt_pk_bf16(float lo, float hi) { unsigned r; asm volatile("v_cvt_pk_bf16_f32 %0, %1, %2" : "=v"(r) : "v"(lo), "v"(hi)); return r; }
__device__ __forceinline__ float sigmoidf_(float x) { return __builtin_amdgcn_rcpf(1.0f + __expf(-x)); }
template <int O> __device__ __forceinline__ float swz_xor(float v) { return __int_as_float(__builtin_amdgcn_ds_swizzle(__float_as_int(v), (O << 10) | 0x1f)); }
__device__ __forceinline__ float wave_sum(float v, int lane) {
    v += swz_xor<1>(v); v += swz_xor<2>(v); v += swz_xor<4>(v); v += swz_xor<8>(v); v += swz_xor<16>(v);
    v += __int_as_float(__builtin_amdgcn_ds_bpermute((lane ^ 32) << 2, __float_as_int(v)));
    return v;
}
__device__ __forceinline__ void unpack8(const u32x4 v, float* o) {
    o[0] = __uint_as_float(v.x << 16); o[1] = __uint_as_float(v.x & 0xffff0000u);
    o[2] = __uint_as_float(v.y << 16); o[3] = __uint_as_float(v.y & 0xffff0000u);
    o[4] = __uint_as_float(v.z << 16); o[5] = __uint_as_float(v.z & 0xffff0000u);
    o[6] = __uint_as_float(v.w << 16); o[7] = __uint_as_float(v.w & 0xffff0000u);
}

struct RsRaw { f32x4 a, b, c, d; };
__device__ __forceinline__ RsRaw rs_load(const float* part) { RsRaw r; r.a = *(const f32x4*)part; r.b = *(const f32x4*)(part + 4); r.c = *(const f32x4*)(part + 8); r.d = *(const f32x4*)(part + 12); return r; }
__device__ __forceinline__ float rs_finish(const RsRaw& r) {
    const float s = (((r.a[0] + r.a[1]) + (r.a[2] + r.a[3])) + ((r.b[0] + r.b[1]) + (r.b[2] + r.b[3]))) + (((r.c[0] + r.c[1]) + (r.c[2] + r.c[3])) + ((r.d[0] + r.d[1]) + (r.d[2] + r.d[3])));
    return 1.0f / sqrtf(s * (1.f / DM) + EPS);
}
namespace pg8 {
constexpr int BM = 256, BK = 64, HALF = 128, HTB = HALF * BK * 2, STAGE_BYTES = 8 * HTB, NXCD = 8, WGM = 8;
__host__ __device__ __forceinline__ int lds_byte(int r, int c) { const int st = (r >> 4) * 2 + (c >> 5), rr = r & 15, cc = c & 31, ob = rr * 64 + cc * 2; return st * 1024 + (ob ^ (((ob >> 9) & 1) << 5)); }
__host__ __device__ __forceinline__ void stage_rc(int b, int& R, int& C) { const int st = b / 1024, sb = b % 1024, swz = sb ^ (((sb >> 9) & 1) << 5); R = (st >> 1) * 16 + swz / 64; C = (st & 1) * 32 + (swz % 64) / 2; }
__host__ __device__ __forceinline__ int perm32(int rho) { const int n = rho >> 4, i = rho & 15; return 8 * (i >> 2) + 4 * n + (i & 3); }

struct Unit { int pm, pn, aux; const char* a; const char* b; };
struct Gemm { int lda, ldb, K; };

struct StaticOrder {
    int nM, nN, nwg, G, c; const char* A; const char* Bt; size_t ta, tb;
    __device__ void init(int M, int N, int G_, int c_, const void* A_, int lda, const void* Bt_, int ldb) {
        nM = M / BM; nN = N / BM; nwg = nM * nN; G = G_; c = c_; A = (const char*)A_; Bt = (const char*)Bt_; ta = (size_t)BM * lda * 2; tb = (size_t)BM * ldb * 2; }
    __device__ bool next(int i, Unit& u) const {
        const long L = (long)i * G + c; if (L >= nwg) return false;
        int wgid = (int)L; { const int q = nwg / NXCD, r = nwg % NXCD, xcd = wgid % NXCD, off = wgid / NXCD; wgid = (xcd < r ? xcd * (q + 1) : r * (q + 1) + (xcd - r) * q) + off; }
        const int nig = WGM * nN, gid = wgid / nig, fm = gid * WGM, gsz = (nM - fm) < WGM ? (nM - fm) : WGM;
        u.pm = fm + ((wgid % nig) % gsz); u.pn = (wgid % nig) / gsz; u.aux = 0; u.a = A + (size_t)u.pm * ta; u.b = Bt + (size_t)u.pn * tb; return true;
    }
};
struct MergeOrder {
    int nM, nN, nwg, G, c; const char* Y; const char* Wb;
    __device__ void init(int M, int G_, int c_, const void* Y_, const void* Wb_) { nM = M / BM; nN = DM / HALF; nwg = nM * nN; G = G_; c = c_; Y = (const char*)Y_; Wb = (const char*)Wb_; }
    __device__ bool next(int i, Unit& u) const {
        const long L = (long)i * G + c; if (L >= nwg) return false;
        int wgid = (int)L; { const int q = nwg / NXCD, r = nwg % NXCD, xcd = wgid % NXCD, off = wgid / NXCD; wgid = (xcd < r ? xcd * (q + 1) : r * (q + 1) + (xcd - r) * q) + off; }
        const int nig = WGM * nN, gid = wgid / nig, fm = gid * WGM, gsz = (nM - fm) < WGM ? (nM - fm) : WGM;
        u.pm = fm + ((wgid % nig) % gsz); u.pn = (wgid % nig) / gsz; u.aux = 0;
        u.a = Y + (size_t)u.pm * BM * DM * 2; u.b = Wb + (size_t)u.pn * HALF * DM * 2; return true;
    }
};

struct EpiSwiglu {
    static constexpr bool PERM = true;
    static constexpr bool NEEDS_RS = true, RS_PLAIN = false, I8 = false;
    unsigned char* ws; unsigned ssq_off;
    __device__ __forceinline__ const float* rs_ptr(int row) const { return (const float*)(ws + WS_SSQ) + ((size_t)ssq_off + row) * 16; }
    __device__ __forceinline__ void operator()(const f32x4 (&acc)[2][2][4][2], const Unit& u, int wr, int wc, int fr, int fq, const LAS float* rsl) const {
        const int row0 = u.pm * BM + wr * 64 + fr, col0 = u.pn * HALF + wc * 32 + 8 * fq;
        bf16* O = (bf16*)(ws + WS_HID);
#pragma unroll
        for (int ai = 0; ai < 2; ++ai)
#pragma unroll
            for (int m = 0; m < 4; ++m) {
                const int row = row0 + ai * HALF + m * 16;
                const float rs = rsl[ai * HALF + wr * 64 + m * 16 + fr];
                float o[8];
#pragma unroll
                for (int n = 0; n < 2; ++n)
#pragma unroll
                    for (int e = 0; e < 4; ++e) { const float g = acc[ai][0][m][n][e] * rs, up = acc[ai][1][m][n][e] * rs; o[n * 4 + e] = g * up * __builtin_amdgcn_rcpf(1.0f + __expf(-g)); }
                u32x4 w; w.x = cvt_pk_bf16(o[0], o[1]); w.y = cvt_pk_bf16(o[2], o[3]); w.z = cvt_pk_bf16(o[4], o[5]); w.w = cvt_pk_bf16(o[6], o[7]);
                __builtin_nontemporal_store(w, (u32x4*)(O + (size_t)row * DFF + col0)); }
    }
};
struct EpiSwiglu8 {
    static constexpr bool PERM = true;
    static constexpr bool NEEDS_RS = true, RS_PLAIN = true, I8 = true;
    unsigned char* ws; unsigned csc_off;
    __device__ __forceinline__ const float* rs_ptr(int row) const { return (const float*)(ws + WS_ROWF) + row; }
    __device__ __forceinline__ void operator()(const f32x4 (&acc)[2][2][4][2], const Unit& u, int wr, int wc, int fr, int fq, const LAS float* rsl) const {
        const int row0 = u.pm * BM + wr * 64 + fr, col0 = u.pn * HALF + wc * 32 + 8 * fq;
        bf16* O = (bf16*)(ws + WS_HID); const float* csc = (const float*)(ws + WS_CSC) + csc_off + u.pn * BM + wc * 32 + 8 * fq;
        f32x4 cv[2][2];
#pragma unroll
        for (int bj = 0; bj < 2; ++bj)
#pragma unroll
            for (int n = 0; n < 2; ++n) cv[bj][n] = *(const f32x4*)(csc + bj * HALF + 4 * n);
#pragma unroll
        for (int ai = 0; ai < 2; ++ai)
#pragma unroll
            for (int m = 0; m < 4; ++m) {
                const int row = row0 + ai * HALF + m * 16;
                const float rs = rsl[ai * HALF + wr * 64 + m * 16 + fr];
                float o[8];
#pragma unroll
                for (int n = 0; n < 2; ++n)
#pragma unroll
                    for (int e = 0; e < 4; ++e) { const float g = (float)__float_as_int(acc[ai][0][m][n][e]) * (rs * cv[0][n][e]), up = (float)__float_as_int(acc[ai][1][m][n][e]) * (rs * cv[1][n][e]);
                        o[n * 4 + e] = g * up * __builtin_amdgcn_rcpf(1.0f + __expf(-g)); }
                u32x4 w; w.x = cvt_pk_bf16(o[0], o[1]); w.y = cvt_pk_bf16(o[2], o[3]); w.z = cvt_pk_bf16(o[4], o[5]); w.w = cvt_pk_bf16(o[6], o[7]);
                __builtin_nontemporal_store(w, (u32x4*)(O + (size_t)row * DFF + col0)); }
    }
};
struct EpiResid {
    static constexpr bool PERM = true;
    static constexpr bool NEEDS_RS = false, RS_PLAIN = false, I8 = false;
    float* out; float scale; unsigned char* ws; unsigned x_off, ssq_off; bool feed, fin;
    __device__ __forceinline__ const float* rs_ptr(int) const { return nullptr; }
    __device__ __forceinline__ void operator()(const f32x4 (&acc)[2][2][4][2], const Unit& u, int wr, int wc, int fr, int fq, const LAS float*) const {
        const int row0 = u.pm * BM + wr * 64 + fr, col0 = u.pn * BM + wc * 32 + 8 * fq;
        const int lane = fq * 16 + fr;
        bf16* xb = (bf16*)(ws + WS_HN) + x_off; float* ssq = (float*)(ws + WS_SSQ) + (size_t)ssq_off * 16;
#pragma unroll
        for (int ai = 0; ai < 2; ++ai)
#pragma unroll
            for (int m = 0; m < 4; ++m) { const size_t off = (size_t)(row0 + ai * HALF + m * 16) * DM + col0; float q = 0.f;
#pragma unroll
                for (int bj = 0; bj < 2; ++bj) {
                    float x[8]; unpack8(*(const u32x4*)(xb + off + bj * HALF), x);
#pragma unroll
                    for (int e = 0; e < 4; ++e) { x[e] += acc[ai][bj][m][0][e] * scale; x[4 + e] += acc[ai][bj][m][1][e] * scale; }
                    if (fin) { *(f32x4*)(out + x_off + off + bj * HALF) = (f32x4){x[0], x[1], x[2], x[3]}; *(f32x4*)(out + x_off + off + bj * HALF + 4) = (f32x4){x[4], x[5], x[6], x[7]}; }
                    else { u32x4 w; w.x = cvt_pk_bf16(x[0], x[1]); w.y = cvt_pk_bf16(x[2], x[3]); w.z = cvt_pk_bf16(x[4], x[5]); w.w = cvt_pk_bf16(x[6], x[7]); *(u32x4*)(xb + off + bj * HALF) = w;
                        if (feed) { float r[8]; unpack8(w, r);
#pragma unroll
                            for (int e = 0; e < 8; ++e) q += r[e] * r[e]; } } }
                if (feed) { q += swz_xor<16>(q); q += __int_as_float(__builtin_amdgcn_ds_bpermute((lane ^ 32) << 2, __float_as_int(q)));
                    if (fq == 0) ssq[(size_t)(row0 + ai * HALF + m * 16) * 16 + u.pn * 4 + wc] = q; } }
    }
};
struct EpiWin {
    static constexpr bool PERM = true;
    static constexpr bool NEEDS_RS = true, RS_PLAIN = false, I8 = false;
    unsigned char* ws; unsigned pb_off, ssq_off; bool gphase;
    __device__ __forceinline__ const float* rs_ptr(int row) const { return (const float*)(ws + WS_SSQ) + ((size_t)ssq_off + row) * 16; }
    __device__ __forceinline__ void operator()(const f32x4 (&acc)[2][2][4][2], const Unit& u, int wr, int wc, int fr, int fq, const LAS float* rsl) const {
        const int row0 = u.pm * BM + wr * 64 + fr;
        bf16* proj = (bf16*)(ws + WS_PROJ); bf16* gates = (bf16*)(ws + WS_GATES); const float* gbias = (const float*)(ws + WS_PB) + pb_off;
        const bool isg = gphase;
        const int colt = u.pn * BM + wc * 32 + 8 * fq;
        f32x4 bv[2][2];
#pragma unroll
        for (int bj = 0; bj < 2; ++bj)
#pragma unroll
            for (int n = 0; n < 2; ++n) bv[bj][n] = isg ? *(const f32x4*)(gbias + colt + bj * HALF + 4 * n) : (f32x4){0.f, 0.f, 0.f, 0.f};
#pragma unroll
        for (int ai = 0; ai < 2; ++ai)
#pragma unroll
            for (int m = 0; m < 4; ++m) { const int rr = row0 + ai * HALF + m * 16;
                const float rs = rsl[ai * HALF + wr * 64 + m * 16 + fr];
#pragma unroll
                for (int bj = 0; bj < 2; ++bj) { f32x4 v0 = acc[ai][bj][m][0] * rs + bv[bj][0], v1 = acc[ai][bj][m][1] * rs + bv[bj][1];
                    if (isg) {
#pragma unroll
                        for (int e = 0; e < 4; ++e) { v0[e] = __builtin_amdgcn_rcpf(1.0f + __expf(-v0[e])); v1[e] = __builtin_amdgcn_rcpf(1.0f + __expf(-v1[e])); } }
                    const size_t eidx = ((size_t)((colt + bj * HALF) >> 6) * MH + rr) * 64 + ((colt + bj * HALF) & 63);
                    if (isg) {
                        u32x2 w = {0u, 0u};
                        w.x = __builtin_amdgcn_cvt_pk_u8_f32(v0[0] * 255.0f, 0, w.x); w.x = __builtin_amdgcn_cvt_pk_u8_f32(v0[1] * 255.0f, 1, w.x); w.x = __builtin_amdgcn_cvt_pk_u8_f32(v0[2] * 255.0f, 2, w.x); w.x = __builtin_amdgcn_cvt_pk_u8_f32(v0[3] * 255.0f, 3, w.x);
                        w.y = __builtin_amdgcn_cvt_pk_u8_f32(v1[0] * 255.0f, 0, w.y); w.y = __builtin_amdgcn_cvt_pk_u8_f32(v1[1] * 255.0f, 1, w.y); w.y = __builtin_amdgcn_cvt_pk_u8_f32(v1[2] * 255.0f, 2, w.y); w.y = __builtin_amdgcn_cvt_pk_u8_f32(v1[3] * 255.0f, 3, w.y);
                        __builtin_nontemporal_store(w, (u32x2*)((unsigned char*)gates + eidx));
                    } else {
                        u32x4 w; w.x = cvt_pk_bf16(v0[0], v0[1]); w.y = cvt_pk_bf16(v0[2], v0[3]); w.z = cvt_pk_bf16(v1[0], v1[1]); w.w = cvt_pk_bf16(v1[2], v1[3]);
                        __builtin_nontemporal_store(w, (u32x4*)(proj + eidx)); } } }
    }
};
struct EpiGate8 {
    static constexpr bool PERM = true;
    static constexpr bool NEEDS_RS = true, RS_PLAIN = true, I8 = true;
    unsigned char* ws; unsigned pb_off, csc_off;
    __device__ __forceinline__ const float* rs_ptr(int row) const { return (const float*)(ws + WS_ROWF) + row; }
    __device__ __forceinline__ void operator()(const f32x4 (&acc)[2][2][4][2], const Unit& u, int wr, int wc, int fr, int fq, const LAS float* rsl) const {
        const int row0 = u.pm * BM + wr * 64 + fr;
        unsigned char* gates = ws + WS_GATES; const float* gbias = (const float*)(ws + WS_PB) + pb_off; const float* csc = (const float*)(ws + WS_CSC) + csc_off;
        const int colt = u.pn * BM + wc * 32 + 8 * fq;
        f32x4 bv[2][2], cv[2][2];
#pragma unroll
        for (int bj = 0; bj < 2; ++bj)
#pragma unroll
            for (int n = 0; n < 2; ++n) { bv[bj][n] = *(const f32x4*)(gbias + colt + bj * HALF + 4 * n); cv[bj][n] = *(const f32x4*)(csc + colt + bj * HALF + 4 * n); }
#pragma unroll
        for (int ai = 0; ai < 2; ++ai)
#pragma unroll
            for (int m = 0; m < 4; ++m) { const int rr = row0 + ai * HALF + m * 16;
                const float rs = rsl[ai * HALF + wr * 64 + m * 16 + fr];
#pragma unroll
                for (int bj = 0; bj < 2; ++bj) { f32x4 v0, v1;
#pragma unroll
                    for (int e = 0; e < 4; ++e) {
                        v0[e] = (float)__float_as_int(acc[ai][bj][m][0][e]) * (rs * cv[bj][0][e]) + bv[bj][0][e]; v1[e] = (float)__float_as_int(acc[ai][bj][m][1][e]) * (rs * cv[bj][1][e]) + bv[bj][1][e];
                        v0[e] = __builtin_amdgcn_rcpf(1.0f + __expf(-v0[e])); v1[e] = __builtin_amdgcn_rcpf(1.0f + __expf(-v1[e])); }
                    const size_t eidx = ((size_t)((colt + bj * HALF) >> 6) * MH + rr) * 64 + ((colt + bj * HALF) & 63);
                    u32x2 w = {0u, 0u};
                    w.x = __builtin_amdgcn_cvt_pk_u8_f32(v0[0] * 255.0f, 0, w.x); w.x = __builtin_amdgcn_cvt_pk_u8_f32(v0[1] * 255.0f, 1, w.x); w.x = __builtin_amdgcn_cvt_pk_u8_f32(v0[2] * 255.0f, 2, w.x); w.x = __builtin_amdgcn_cvt_pk_u8_f32(v0[3] * 255.0f, 3, w.x);
                    w.y = __builtin_amdgcn_cvt_pk_u8_f32(v1[0] * 255.0f, 0, w.y); w.y = __builtin_amdgcn_cvt_pk_u8_f32(v1[1] * 255.0f, 1, w.y); w.y = __builtin_amdgcn_cvt_pk_u8_f32(v1[2] * 255.0f, 2, w.y); w.y = __builtin_amdgcn_cvt_pk_u8_f32(v1[3] * 255.0f, 3, w.y);
                    __builtin_nontemporal_store(w, (u32x2*)(gates + eidx)); } }
    }
};
struct EpiMerge {
    static constexpr bool PERM = true;
    static constexpr bool NEEDS_RS = false, RS_PLAIN = false, I8 = false;
    unsigned char* ws;
    __device__ __forceinline__ const float* rs_ptr(int) const { return nullptr; }
    __device__ __forceinline__ void gate_load(u32x2 (&gv)[2][4], const Unit& u, int nb, int wr, int wc, int fr, int fq) const {
        const int row0 = u.pm * BM + wr * 64 + fr, col0 = u.pn * HALF + wc * 32 + 8 * fq;
        const unsigned char* gates = (const unsigned char*)(ws + WS_GATES);
#pragma unroll
        for (int ai = 0; ai < 2; ++ai)
#pragma unroll
            for (int m = 0; m < 4; ++m) gv[ai][m] = *(const u32x2*)(gates + (((size_t)((nb * DM + col0) >> 6) * MH + (row0 + ai * HALF + m * 16)) * 64 + ((nb * DM + col0) & 63)));
    }
    __device__ __forceinline__ void hook(f32x4 (&acc)[2][2][4][2], const u32x2 (&gv)[2][4]) const {
#pragma unroll
        for (int ai = 0; ai < 2; ++ai)
#pragma unroll
            for (int m = 0; m < 4; ++m) {
#pragma unroll
                for (int e = 0; e < 4; ++e) { acc[ai][1][m][0][e] += (float)((gv[ai][m].x >> (8 * e)) & 0xffu) * acc[ai][0][m][0][e]; acc[ai][1][m][1][e] += (float)((gv[ai][m].y >> (8 * e)) & 0xffu) * acc[ai][0][m][1][e]; }
                acc[ai][0][m][0] = (f32x4){0.f, 0.f, 0.f, 0.f}; acc[ai][0][m][1] = (f32x4){0.f, 0.f, 0.f, 0.f}; }
    }
    __device__ __forceinline__ void operator()(const f32x4 (&acc)[2][2][4][2], const Unit& u, int wr, int wc, int fr, int fq, const LAS float*) const {
        const int row0 = u.pm * BM + wr * 64 + fr, col0 = u.pn * HALF + wc * 32 + 8 * fq;
        bf16* merged = (bf16*)(ws + WS_MERGED);
#pragma unroll
        for (int ai = 0; ai < 2; ++ai)
#pragma unroll
            for (int m = 0; m < 4; ++m) { const f32x4 v0 = acc[ai][1][m][0] * (1.0f / 255.0f), v1 = acc[ai][1][m][1] * (1.0f / 255.0f);
                u32x4 w; w.x = cvt_pk_bf16(v0[0], v0[1]); w.y = cvt_pk_bf16(v0[2], v0[3]); w.z = cvt_pk_bf16(v1[0], v1[1]); w.w = cvt_pk_bf16(v1[2], v1[3]);
                *(u32x4*)(merged + (size_t)(row0 + ai * HALF + m * 16) * DM + col0) = w; }
    }
};

template <bool I8> __device__ __forceinline__ f32x4 mma1(const bf16x8 b, const bf16x8 a, const f32x4 c) {
    if constexpr (I8) return __builtin_bit_cast(f32x4, __builtin_amdgcn_mfma_i32_16x16x64_i8(__builtin_bit_cast(i32x4, b), __builtin_bit_cast(i32x4, a), __builtin_bit_cast(i32x4, c), 0, 0, 0));
    else return __builtin_amdgcn_mfma_f32_16x16x32_bf16(b, a, c, 0, 0, 0);
}
template <class Epi, class Sched, bool ALIGN_EPI, bool HALFN = false>
__device__ __forceinline__ void gemm_phase(LAS unsigned char* lds, const int tid, const Gemm g, const Sched& S, const Epi& E) {
    const int wid = __builtin_amdgcn_readfirstlane(tid >> 6), lane = tid & 63, wr = wid >> 2, wc = wid & 3, fr = lane & 15, fq = lane >> 4;
    int K = g.K; asm volatile("" : "+s"(K));
    const int nt = K / BK;
    unsigned voffA[2], voffB[2];
#pragma unroll
    for (int i = 0; i < 2; ++i) { int R, C; stage_rc(tid * 16 + i * 8192, R, C); const int Rb = Epi::PERM ? ((R & ~31) + perm32(R & 31)) : R;
        voffA[i] = (unsigned)(R * g.lda + C) * 2u; voffB[i] = (unsigned)(Rb * g.ldb + C) * 2u; }
    const size_t kstep = (size_t)(BK * 2);
    const size_t hstepA = (size_t)HALF * g.lda * 2, hstepB = (size_t)HALF * g.ldb * 2;
    const unsigned ldsw = (unsigned)wid * 1024u;
    const int aoff = lds_byte(wr * 64 + fr, fq * 8), boff = lds_byte(wc * 32 + fr, fq * 8);
#define PG8_SA(b, h) (((b) * 2 + (h)) * HTB)
#define PG8_SB(b, h) ((4 + (b) * 2 + (h)) * HTB)
#define PG8_STAGE(bufoff, gbase, voff) do { _Pragma("unroll") for (int _i = 0; _i < 2; ++_i) \
        __builtin_amdgcn_global_load_lds((const unsigned*)((const char*)(gbase) + (voff)[_i]), (LAS unsigned*)(lds + (bufoff) + ldsw + _i * 8192), 16, 0, 0); } while (0)
#define PG8_LDA(dst, b, h) do { _Pragma("unroll") for (int m = 0; m < 4; ++m) _Pragma("unroll") for (int k = 0; k < 2; ++k) dst[m][k] = *(const LAS bf16x8*)(lds + PG8_SA(b, h) + aoff + m * 2048 + k * 1024); } while (0)
#define PG8_LDB(dst, b, h) do { _Pragma("unroll") for (int n = 0; n < 2; ++n) _Pragma("unroll") for (int k = 0; k < 2; ++k) dst[n][k] = *(const LAS bf16x8*)(lds + PG8_SB(b, h) + boff + n * 2048 + k * 1024); } while (0)
#define PG8_MMA(ai, bj, At, Bt) do { __builtin_amdgcn_s_setprio(1); _Pragma("unroll") for (int m = 0; m < 4; ++m) _Pragma("unroll") for (int n = 0; n < 2; ++n) _Pragma("unroll") for (int k = 0; k < 2; ++k) \
        acc[ai][bj][m][n] = mma1<Epi::I8>(Bt[n][k], At[m][k], acc[ai][bj][m][n]); __builtin_amdgcn_s_setprio(0); } while (0)
#define PG8_WAIT_V(n) asm volatile("s_waitcnt vmcnt(" #n ")" ::: "memory")
#define PG8_WAIT_L(n) asm volatile("s_waitcnt lgkmcnt(" #n ")" ::: "memory")
#define PG8_BAR __builtin_amdgcn_s_barrier()
#define PG8_SCHED __builtin_amdgcn_sched_barrier(0)
    Unit cur, nxt; int ui = 0;
    if (!S.next(0, cur)) return;
    LAS float* RS = (LAS float*)(lds + STAGE_BYTES);
    if constexpr (Epi::NEEDS_RS) { if (tid < 256) { if constexpr (Epi::RS_PLAIN) RS[tid] = *E.rs_ptr(cur.pm * BM + tid); else RS[tid] = rs_finish(rs_load(E.rs_ptr(cur.pm * BM + tid))); } }
    u32x2 gv[2][4];
    if constexpr (HALFN) E.gate_load(gv, cur, 0, wr, wc, fr, fq);
    f32x4 acc[2][2][4][2];
#pragma unroll
    for (int a = 0; a < 2; ++a)
#pragma unroll
        for (int b = 0; b < 2; ++b)
#pragma unroll
            for (int m = 0; m < 4; ++m)
#pragma unroll
                for (int n = 0; n < 2; ++n) acc[a][b][m][n] = (f32x4){0.f, 0.f, 0.f, 0.f};
    bf16x8 At[4][2], B0[2][2], B1[2][2];
    const char* cA = cur.a; const char* cB = cur.b;
    PG8_STAGE(PG8_SB(0, 0), cB, voffB); PG8_STAGE(PG8_SB(0, 1), cB + hstepB, voffB); PG8_STAGE(PG8_SA(0, 0), cA, voffA); PG8_STAGE(PG8_SA(0, 1), cA + hstepA, voffA);
    if (wr == 1) PG8_BAR;
    PG8_WAIT_V(2); PG8_BAR;
    PG8_STAGE(PG8_SB(1, 0), cB + kstep, voffB); PG8_STAGE(PG8_SA(1, 0), cA + kstep, voffA); PG8_STAGE(PG8_SB(1, 1), cB + hstepB + kstep, voffB);
    PG8_WAIT_V(6); PG8_BAR;
    for (;;) {
        const bool has_next = S.next(ui + 1, nxt);
        const char* nA = has_next ? nxt.a : cA; const char* nB = has_next ? nxt.b : cB;
        for (int t = 0; t < nt; t += 2) {
            const bool last = (t == nt - 2);
            const char* a1 = cA + (size_t)(t + 1) * kstep;
            const char* a2 = last ? nA : cA + (size_t)(t + 2) * kstep; const char* b2 = last ? nB : cB + (size_t)(t + 2) * kstep;
            const char* a3 = a2 + kstep; const char* b3 = b2 + kstep;
            PG8_LDB(B0, 0, 0); if constexpr (!HALFN) PG8_LDB(B1, 0, 1); PG8_SCHED; PG8_LDA(At, 0, 0); PG8_STAGE(PG8_SA(1, 1), a1 + hstepA, voffA);
            PG8_WAIT_V(8); PG8_WAIT_L(0); PG8_BAR; PG8_MMA(0, 0, At, B0); if constexpr (!HALFN) PG8_MMA(0, 1, At, B1); PG8_BAR; PG8_SCHED;
            PG8_LDA(At, 0, 1); PG8_STAGE(PG8_SB(0, 0), b2, voffB); PG8_STAGE(PG8_SB(0, 1), b2 + hstepB, voffB); PG8_STAGE(PG8_SA(0, 0), a2, voffA);
            PG8_WAIT_V(8); PG8_WAIT_L(0); PG8_BAR; PG8_MMA(1, 0, At, B0); if constexpr (!HALFN) PG8_MMA(1, 1, At, B1); PG8_BAR; PG8_SCHED;
            PG8_LDB(B0, 1, 0); if constexpr (!HALFN) PG8_LDB(B1, 1, 1); PG8_SCHED; PG8_LDA(At, 1, 0); PG8_STAGE(PG8_SA(0, 1), a2 + hstepA, voffA);
            PG8_WAIT_V(8); PG8_WAIT_L(0); PG8_BAR; PG8_MMA(0, 0, At, B0); if constexpr (!HALFN) PG8_MMA(0, 1, At, B1); PG8_BAR; PG8_SCHED;
            PG8_LDA(At, 1, 1); PG8_STAGE(PG8_SB(1, 0), b3, voffB); PG8_STAGE(PG8_SB(1, 1), b3 + hstepB, voffB); PG8_STAGE(PG8_SA(1, 0), a3, voffA);
            PG8_WAIT_V(8); PG8_WAIT_L(0); PG8_BAR; PG8_MMA(1, 0, At, B0); if constexpr (!HALFN) PG8_MMA(1, 1, At, B1); PG8_BAR; PG8_SCHED;
            if constexpr (HALFN) { if ((t & 3) == 2) {
                E.hook(acc, gv);
                const int el = lane_id(); int ewr = wr, ewc = wc; asm volatile("" : "+s"(ewr), "+s"(ewc));
                if (!last) E.gate_load(gv, cur, (t >> 2) + 1, ewr, ewc, el & 15, el >> 4);
                else if (has_next) E.gate_load(gv, nxt, 0, ewr, ewc, el & 15, el >> 4); } }
        }
        if constexpr (ALIGN_EPI) { if (wr == 0) PG8_BAR; }
        { const int el = lane_id(); const int efr = el & 15, efq = el >> 4; int ewr = wr, ewc = wc; asm volatile("" : "+s"(ewr), "+s"(ewc));
          RsRaw nraw; nraw.a = nraw.b = nraw.c = nraw.d = (f32x4){0.f, 0.f, 0.f, 0.f};
          if constexpr (Epi::NEEDS_RS) { if (has_next && ewr == 0) { if constexpr (Epi::RS_PLAIN) nraw.a[0] = *E.rs_ptr(nxt.pm * BM + ewc * 64 + el); else nraw = rs_load(E.rs_ptr(nxt.pm * BM + ewc * 64 + el)); } }
          E(acc, cur, ewr, ewc, efr, efq, RS + (ui & 1) * 256);
          if constexpr (Epi::NEEDS_RS) { if (has_next && ewr == 0) { if constexpr (Epi::RS_PLAIN) RS[((ui + 1) & 1) * 256 + ewc * 64 + el] = nraw.a[0]; else RS[((ui + 1) & 1) * 256 + ewc * 64 + el] = rs_finish(nraw); } } }
        if (!has_next) break;
#pragma unroll
        for (int a = 0; a < 2; ++a)
#pragma unroll
            for (int b = 0; b < 2; ++b)
#pragma unroll
                for (int m = 0; m < 4; ++m)
#pragma unroll
                    for (int n = 0; n < 2; ++n) acc[a][b][m][n] = (f32x4){0.f, 0.f, 0.f, 0.f};
        cur = nxt; cA = nA; cB = nB; ++ui;
        if constexpr (ALIGN_EPI) { if (wr == 1) PG8_BAR; }
    }
    PG8_WAIT_V(0);
    if constexpr (!ALIGN_EPI) { if (wr == 0) PG8_BAR; }
    PG8_BAR;
#undef PG8_SA
#undef PG8_SB
#undef PG8_STAGE
#undef PG8_LDA
#undef PG8_LDB
#undef PG8_MMA
#undef PG8_WAIT_V
#undef PG8_WAIT_L
#undef PG8_BAR
#undef PG8_SCHED
}
}

#define XB_TMO      128
#define XB_XCNT(j)  (256  + 64 * (j))
#define XB_XSUB(j)  (1280 + 64 * (j))
#define XB_XGEN(j)  (2304 + 64 * (j))
#define XB_TOP      3328
#define XB_TOPGEN   3392
#define XCD_BAR_WORDS 3456
#define XB_SPIN_CAP (1u << 18)
__device__ __forceinline__ unsigned xb_ld(unsigned* p)              { return __hip_atomic_load(p, __ATOMIC_RELAXED, __HIP_MEMORY_SCOPE_AGENT); }
__device__ __forceinline__ unsigned xb_add(unsigned* p, unsigned v) { return __hip_atomic_fetch_add(p, v, __ATOMIC_RELAXED, __HIP_MEMORY_SCOPE_AGENT); }
__device__ __forceinline__ unsigned xb_xcc_id() { return (unsigned)__builtin_amdgcn_s_getreg((3 << 11) | 20) & 0xFu; }
#define XB_SPIN(cond, bar) do { unsigned _sp = 0; while (cond) { __builtin_amdgcn_s_sleep(1); \
    if ((++_sp & 255u) == 0u) { if (xb_ld(&(bar)[XB_TMO])) break; if (_sp > XB_SPIN_CAP) { atomicAdd(&(bar)[XB_TMO], 1u); break; } } } } while (0)
struct XcdBarrier { unsigned* bar; unsigned x; volatile LAS unsigned* st; int wave; };
__device__ __forceinline__ XcdBarrier xcd_barrier_post(unsigned* bar, volatile LAS unsigned* st, int wave) {
    XcdBarrier b; b.bar = bar; b.x = xb_xcc_id(); b.st = st; b.wave = wave;
    if (wave == 0 && lane_id() == 0) (void)xb_add(&bar[XB_XCNT(b.x)], 1u);
    return b;
}
__device__ __forceinline__ void xcd_barrier_complete(unsigned* bar, unsigned x, unsigned& nloc, unsigned& nx) {
    const unsigned G = gridDim.x * gridDim.y * gridDim.z;
    unsigned sum, cnt, mine, sp = 0u;
    for (;;) {
        sum = 0u; cnt = 0u; mine = 0u;
#pragma unroll
        for (unsigned j = 0; j < 16; ++j) { const unsigned c = xb_ld(&bar[XB_XCNT(j)]); sum += c; cnt += (c > 0u) ? 1u : 0u; mine = (j == x) ? c : mine; }
        if (sum == G) break;
        __builtin_amdgcn_s_sleep(1);
        if ((++sp & 255u) == 0u) { if (xb_ld(&bar[XB_TMO])) break; if (sp > XB_SPIN_CAP) { atomicAdd(&bar[XB_TMO], 1u); break; } }
    }
    nloc = mine > 0u ? mine : 1u; nx = cnt > 0u ? cnt : 1u;
}
__device__ __forceinline__ void xcd_barrier(const XcdBarrier& b) {
    asm volatile("s_waitcnt vmcnt(0)" ::: "memory");
    __syncthreads();
    if (b.wave == 0 && lane_id() == 0) {
        unsigned* bar = b.bar;
        __builtin_amdgcn_s_waitcnt(0);
        unsigned nloc = b.st[0], nx = b.st[1];
        if (nloc == 0u) { xcd_barrier_complete(bar, b.x, nloc, nx); b.st[0] = nloc; b.st[1] = nx; }
        const unsigned old = xb_add(&bar[XB_XSUB(b.x)], 1u);
        const unsigned gen = old / nloc;
        if (old + 1u == (gen + 1u) * nloc) {
            __builtin_amdgcn_fence(__ATOMIC_RELEASE, "agent");
            asm volatile("s_waitcnt vmcnt(0)" ::: "memory");
            const unsigned og = xb_add(&bar[XB_TOP], 1u);
            const unsigned tg = og / nx;
            if (og + 1u == (tg + 1u) * nx) xb_add(&bar[XB_TOPGEN], 1u);
            else XB_SPIN(xb_ld(&bar[XB_TOPGEN]) == tg, bar);
            __builtin_amdgcn_fence(__ATOMIC_ACQUIRE, "agent");
            xb_add(&bar[XB_XGEN(b.x)], 1u);
            asm volatile("s_waitcnt vmcnt(0)" ::: "memory");
        } else {
            XB_SPIN(xb_ld(&bar[XB_XGEN(b.x)]) == gen, bar);
            __builtin_amdgcn_fence(__ATOMIC_ACQUIRE, "agent");
            asm volatile("s_waitcnt vmcnt(0)" ::: "memory");
        }
    }
    __syncthreads();
}

struct Args { const float* in[28]; float* out; unsigned char* ws; int ph_lo, ph_hi; };
enum { I_X = 0, I_F1N, I_F1G, I_F1U, I_F1D, I_MIXN, I_WIN, I_GBIAS, I_LBL, I_HGN, I_RGW, I_RGB, I_QN, I_KN, I_SINK, I_CW, I_CB, I_WA, I_BA, I_WX, I_BX, I_LAM, I_WBR, I_WOUT, I_F2N, I_F2G, I_F2U, I_F2D };
typedef const float* CFP;
typedef const __attribute__((address_space(4))) CFP* InTab;
template <class T> __device__ __forceinline__ T* as_global(T* p) { return (T*)(GAS T*)p; }
struct InPtrs { InTab t; __device__ __forceinline__ const float* operator[](int i) const { return as_global(t[i]); } };
__host__ __device__ __forceinline__ size_t bm_idx(int row, int col) { return ((size_t)(col >> 6) * MH + row) * 64 + (col & 63); }
struct Ctx {
    LAS unsigned char* lds; int tid, lane, wave, G, bid;
    InPtrs in; float* out; unsigned char* ws;
    bf16 *W, *HN, *HID, *PROJ, *GATES, *MERGED; float *SH, *SR, *HLOC, *PCUM, *DH, *HEND, *PEND, *PB;
};
__device__ __forceinline__ Ctx phase_ctx(const Ctx& K) {
    Ctx C; C.lds = K.lds; C.G = K.G; C.bid = K.bid;
    int lane = lane_id(), wave = K.wave; InTab in = K.in.t; GAS float* outg = (GAS float*)K.out; GAS unsigned char* wsg = (GAS unsigned char*)K.ws;
    asm volatile("" : "+v"(lane)); asm volatile("" : "+s"(wave)); asm volatile("" : "+s"(in)); asm volatile("" : "+s"(outg)); asm volatile("" : "+s"(wsg));
    float* out = (float*)outg; unsigned char* ws = (unsigned char*)wsg;
    C.tid = wave * 64 + lane; C.lane = lane; C.wave = wave; C.in.t = in; C.out = out; C.ws = ws;
    C.W = (bf16*)(ws + WS_W); C.HN = (bf16*)(ws + WS_HN); C.HID = (bf16*)(ws + WS_HID); C.PROJ = (bf16*)(ws + WS_PROJ); C.GATES = (bf16*)(ws + WS_GATES); C.MERGED = (bf16*)(ws + WS_MERGED);
    C.SH = (float*)(ws + WS_SH); C.SR = (float*)(ws + WS_SR); C.HLOC = nullptr; C.PCUM = nullptr; C.DH = (float*)(ws + WS_DH); C.HEND = (float*)(ws + WS_HEND); C.PEND = (float*)(ws + WS_PEND); C.PB = (float*)(ws + WS_PB);
    return C;
}

struct ItemDesc { const float* src; bf16* dst; const float* gain; int ldw, ldt, k0, n0, orow; };
__device__ __forceinline__ void tr_load(const ItemDesc& d, float (&r)[32], int lane) {
#pragma unroll
    for (int i = 0; i < 32; ++i) r[i] = d.src[(size_t)(d.k0 + 2 * i + (lane >> 5)) * d.ldw + d.n0 + (lane & 31)];
}
__device__ __forceinline__ void tr_finish(const ItemDesc& d, const float (&r)[32], LAS float* scr, int lane) {
#pragma unroll
    for (int i = 0; i < 32; ++i) scr[(2 * i + (lane >> 5)) * 33 + (lane & 31)] = r[i];
    asm volatile("s_waitcnt lgkmcnt(0)" ::: "memory");
    const int c = lane & 7;
    f32x4 g0 = {1.f, 1.f, 1.f, 1.f}, g1 = g0;
    if (d.gain) { g0 = *(const f32x4*)(d.gain + d.k0 + 8 * c); g1 = *(const f32x4*)(d.gain + d.k0 + 8 * c + 4); }
#pragma unroll
    for (int j = 0; j < 4; ++j) { const int n = (lane >> 3) + 8 * j; const LAS float* s = scr + (8 * c) * 33 + n;
        u32x4 o; o.x = pk2(s[0 * 33] * g0[0], s[1 * 33] * g0[1]); o.y = pk2(s[2 * 33] * g0[2], s[3 * 33] * g0[3]); o.z = pk2(s[4 * 33] * g1[0], s[5 * 33] * g1[1]); o.w = pk2(s[6 * 33] * g1[2], s[7 * 33] * g1[3]);
        *(u32x4*)(d.dst + (size_t)(d.n0 + d.orow + n) * d.ldt + d.k0 + 8 * c) = o; }
    asm volatile("s_waitcnt lgkmcnt(0)" ::: "memory");
}
constexpr int IT_FF = 16 * 88, IT_FFN = 6 * IT_FF, IT_WIN = 16 * 224, IT_WB = 512, IT_WOUT = 512, IT_LAYER = IT_FFN + IT_WIN + IT_WB + IT_WOUT;
static_assert((DFF / 64) * (DM / 32) == IT_FF, "wd items == gate items");
__device__ __forceinline__ ItemDesc decode_item(const Ctx& C, int it) {
    ItemDesc d; d.gain = nullptr; d.orow = 0;
    const int l = it / IT_LAYER; int r = it % IT_LAYER;
    bf16* WL = C.W + (size_t)l * E_LAYER;
    if (r < IT_FFN) {
        const int s = r / IT_FF, q = r % IT_FF, f = s / 3, kind = s % 3;
        if (kind < 2) {
            const int kb = q / 88, nb = q % 88, n0 = 32 * nb;
            d.src = (f == 0 ? (kind == 0 ? C.in[I_F1G] : C.in[I_F1U]) : (kind == 0 ? C.in[I_F2G] : C.in[I_F2U])) + (size_t)l * DM * DFF;
            d.ldw = DFF; d.k0 = 64 * kb; d.n0 = n0; d.dst = WL + (f == 0 ? O_WGU1 : O_WGU2); d.ldt = DM; d.orow = 256 * (n0 / 128) + (n0 % 128) + 128 * kind - n0;
            d.gain = (f == 0 ? C.in[I_F1N] : C.in[I_F2N]) + l * DM;
        } else {
            const int kb = q / 32, nb = q % 32;
            d.src = (f == 0 ? C.in[I_F1D] : C.in[I_F2D]) + (size_t)l * DFF * DM; d.ldw = DM; d.k0 = 64 * kb; d.n0 = 32 * nb; d.dst = WL + (f == 0 ? O_WD1 : O_WD2); d.ldt = DFF;
        }
        return d;
    }
    r -= IT_FFN;
    if (r < IT_WIN) { const int kb = r / 224, nb = r % 224; d.src = C.in[I_WIN] + (size_t)l * DM * DIN; d.ldw = DIN; d.k0 = 64 * kb; d.n0 = 32 * nb; d.dst = WL + O_WIN; d.ldt = DM; d.gain = C.in[I_MIXN] + l * DM; return d; }
    r -= IT_WIN;
    if (r < IT_WB) { const int n = r / 128, q = r % 128, kb = q / 32, nb = q % 32; d.src = C.in[I_WBR] + (size_t)(l * 4 + n) * 256 * DM; d.ldw = DM; d.k0 = 64 * kb; d.n0 = 32 * nb; d.dst = WL + O_WB + (size_t)n * 256; d.ldt = DM; return d; }
    r -= IT_WB;
    { const int kb = r / 32, nb = r % 32; d.src = C.in[I_WOUT] + (size_t)l * DM * DM; d.ldw = DM; d.k0 = 64 * kb; d.n0 = 32 * nb; d.dst = WL + O_WOUT; d.ldt = DM; }
    return d;
}

__device__ __forceinline__ void norm_row(const float* xrow, const float* w, bf16* orow, int lane) {
    const f32x4* xr = (const f32x4*)xrow + lane; const f32x4* wr = (const f32x4*)w + lane;
    f32x4 v[4]; float s = 0.f;
#pragma unroll
    for (int j = 0; j < 4; ++j) { v[j] = xr[64 * j]; s += (v[j].x * v[j].x + v[j].y * v[j].y) + (v[j].z * v[j].z + v[j].w * v[j].w); }
    const float rstd = 1.0f / sqrtf(wave_sum(s, lane) * (1.f / DM) + EPS);
    unsigned long long* o8 = (unsigned long long*)orow + lane;
#pragma unroll
    for (int j = 0; j < 4; ++j) { const f32x4 g = wr[64 * j]; o8[64 * j] = (unsigned long long)pk2(v[j].x * rstd * g.x, v[j].y * rstd * g.y) | ((unsigned long long)pk2(v[j].z * rstd * g.z, v[j].w * rstd * g.w) << 32); }
}
__device__ __forceinline__ void norm_phase(const Ctx& C, const float* x, const float* w, bf16* out) {
    const int gw = C.bid * 8 + C.wave, NGW = C.G * 8;
    for (int m = gw; m < MT; m += NGW) norm_row(x + (size_t)m * DM, w, out + (size_t)m * DM, C.lane);
}

__device__ __forceinline__ float hgrn_lb(const float* logits, int l, int w) {
    if (l == 0) return 0.f;
    float mx = logits[w];
#pragma unroll
    for (int j = 1; j < DEPTH; ++j) mx = fmaxf(mx, logits[j * 256 + w]);
    float den = 0.f, num = 0.f;
#pragma unroll
    for (int j = 0; j < DEPTH; ++j) { const float e = __expf(logits[j * 256 + w] - mx); den += e; if (j >= 1 && j <= l) num += e; }
    return num / den;
}

__device__ __forceinline__ void lds_barrier() { asm volatile("s_waitcnt lgkmcnt(0)\n\ts_barrier" ::: "memory"); }
typedef short s16x4 __attribute__((ext_vector_type(4)));
typedef __bf16 bf16x2_t __attribute__((ext_vector_type(2)));
__device__ __forceinline__ unsigned pkbf(float a, float b) { const f32x2 f = {a, b}; return __builtin_bit_cast(unsigned, __builtin_convertvector(f, bf16x2_t)); }
__device__ __forceinline__ bf16x8 pack8(const f32x4 lo, const f32x4 hi) { u32x4 p; p.x = pkbf(lo[0], lo[1]); p.y = pkbf(lo[2], lo[3]); p.z = pkbf(hi[0], hi[1]); p.w = pkbf(hi[2], hi[3]); return __builtin_bit_cast(bf16x8, p); }
__device__ __forceinline__ f32x4 mfma16(const bf16x8 a, const bf16x8 b, const f32x4 c) { return __builtin_amdgcn_mfma_f32_16x16x32_bf16(a, b, c, 0, 0, 0); }
__device__ __forceinline__ bf16x8 ldsfrag(const LAS unsigned char* p) { return *(const LAS bf16x8*)p; }
constexpr int RS = 144;
__device__ __forceinline__ bf16x8 trfrag(const LAS unsigned char* img, int r0, int r1, int c0, int fr) {
    const int q = fr >> 2, p = fr & 3;
    const s16x4 lo = __builtin_amdgcn_ds_read_tr16_b64_v4i16((LAS s16x4*)(img + (r0 + q) * RS + (c0 + 4 * p) * 2));
    const s16x4 hi = __builtin_amdgcn_ds_read_tr16_b64_v4i16((LAS s16x4*)(img + (r1 + q) * RS + (c0 + 4 * p) * 2));
    return __builtin_shufflevector(lo, hi, 0, 1, 2, 3, 4, 5, 6, 7);
}
__device__ __forceinline__ float sum16(float v) { v += swz_xor<1>(v); v += swz_xor<2>(v); v += swz_xor<4>(v); v += swz_xor<8>(v); return v; }
__device__ __forceinline__ float xor32f(float v, int lane) { return __int_as_float(__builtin_amdgcn_ds_bpermute((lane ^ 32) << 2, __float_as_int(v))); }
__device__ __forceinline__ float sum4g(float v, int lane) { v += swz_xor<16>(v); v += xor32f(v, lane); return v; }
__device__ __forceinline__ float max4g(float v, int lane) { v = fmaxf(v, swz_xor<16>(v)); v = fmaxf(v, xor32f(v, lane)); return v; }

struct RetRegs { u32x4 rq[2], rk[2], rv[2]; float s[8]; };
template <bool OUT>
__device__ __forceinline__ void ret_load(const Ctx& C, int bl, int seg, int h, RetRegs& R) {
    int tid = C.tid; asm volatile("" : "+v"(tid));
    const size_t rowbase = (size_t)(bl * SEQ + seg * SEGL);
    const float* Sg = C.SR + ((size_t)((bl * NSEG + seg) * 4 + h)) * 4096;
#pragma unroll
    for (int i = 0; i < 2; ++i) {
        const int idx = tid + 512 * i, row = idx >> 3, c8 = idx & 7, prow = (int)rowbase + row;
        if (OUT) R.rq[i] = *(const u32x4*)(C.PROJ + bm_idx(prow, 1024 + h * 64 + 8 * c8));
        R.rk[i] = *(const u32x4*)(C.PROJ + bm_idx(prow, 1280 + h * 64 + 8 * c8));
        R.rv[i] = *(const u32x4*)(C.PROJ + bm_idx(prow, 1536 + h * 64 + 8 * c8));
    }
    if (OUT) {
#pragma unroll
        for (int e = 0; e < 8; ++e) R.s[e] = Sg[(8 * (tid >> 6) + e) * 64 + (tid & 63)];
    }
}
template <bool OUT>
__device__ __forceinline__ void ret_unit_mfma(const Ctx& C, int l, int hb, int bl, int seg, int h, RetRegs& R, bool hn, int un) {
    LAS unsigned char* Qi = C.lds;
    LAS unsigned char* Ki = Qi + 128 * RS;
    LAS unsigned char* Vi = Ki + 128 * RS;
    LAS unsigned char* Si = Vi + 128 * RS;
    const int tid = C.tid, lane = C.lane, w = C.wave, fr = lane & 15, fq = lane >> 4;
    const size_t rowbase = (size_t)(bl * SEQ + seg * SEGL);
    const float lg = __log2f(1.0f - exp2f(-5.0f - (float)h));
    float* Sg = C.SR + ((size_t)((bl * NSEG + seg) * 4 + h)) * 4096;
    u32x4 (&rq)[2] = R.rq; u32x4 (&rk)[2] = R.rk; u32x4 (&rv)[2] = R.rv; float (&s)[8] = R.s;
    lds_barrier();
#pragma unroll
    for (int i = 0; i < 2; ++i) {
        const int idx = tid + 512 * i, row = idx >> 3, c8 = idx & 7;
        if (OUT) *(LAS u32x4*)(Qi + row * RS + c8 * 16) = rq[i];
        u32x4 kv = rk[i];
        if (!OUT) { float f[8]; unpack8(kv, f); const float sc = exp2f((float)(127 - row) * lg); kv.x = pkbf(f[0] * sc, f[1] * sc); kv.y = pkbf(f[2] * sc, f[3] * sc); kv.z = pkbf(f[4] * sc, f[5] * sc); kv.w = pkbf(f[6] * sc, f[7] * sc); }
        *(LAS u32x4*)(Ki + row * RS + c8 * 16) = kv;
        *(LAS u32x4*)(Vi + row * RS + c8 * 16) = rv[i];
    }
    if (OUT) {
        const int v = tid & 63, kg = tid >> 6;
        u32x4 o; o.x = pkbf(s[0], s[1]); o.y = pkbf(s[2], s[3]); o.z = pkbf(s[4], s[5]); o.w = pkbf(s[6], s[7]);
        *(LAS u32x4*)(Si + v * RS + kg * 16) = o;
    }
    if (hn) ret_load<OUT>(C, un >> 7, (un >> 2) & 31, un & 3, R);
    lds_barrier();
    const f32x4 z4 = {0.f, 0.f, 0.f, 0.f};
    if (!OUT) {
        const int kt = w >> 1, vt0 = (w & 1) * 2;
        f32x4 a0 = z4, a1 = z4;
#pragma unroll
        for (int jb = 0; jb < 4; ++jb) {
            const int j0 = 32 * jb + 8 * fq;
            const bf16x8 Af = trfrag(Ki, j0, j0 + 4, 16 * kt, fr);
            a0 = mfma16(Af, trfrag(Vi, j0, j0 + 4, 16 * vt0, fr), a0);
            a1 = mfma16(Af, trfrag(Vi, j0, j0 + 4, 16 * vt0 + 16, fr), a1);
        }
#pragma unroll
        for (int i = 0; i < 4; ++i) { Sg[(16 * kt + 4 * fq + i) * 64 + 16 * vt0 + fr] = a0[i]; Sg[(16 * kt + 4 * fq + i) * 64 + 16 * vt0 + 16 + fr] = a1[i]; }
        return;
    }
    const int t0 = 16 * w;
    float pgw[4], pgb[4];
#pragma unroll
    for (int vt = 0; vt < 4; ++vt) { pgw[vt] = C.PB[l * PB_N + PB_RGW + h * 64 + 16 * vt + fr]; pgb[vt] = C.PB[l * PB_N + PB_RGB + h * 64 + 16 * vt + fr]; }
    bf16 gq[4][4];
#pragma unroll
    for (int i = 0; i < 4; ++i)
#pragma unroll
        for (int vt = 0; vt < 4; ++vt) gq[i][vt] = C.PROJ[bm_idx((int)rowbase + t0 + 4 * fq + i, 1792 + h * 64 + 16 * vt + fr)];
    const bf16x8 Qf0 = ldsfrag(Qi + (t0 + fr) * RS + 16 * fq), Qf1 = ldsfrag(Qi + (t0 + fr) * RS + 16 * fq + 64);
    f32x4 O[4] = {z4, z4, z4, z4};
    for (int jb = 0; jb <= (w >> 1); ++jb) {
        f32x4 s0 = mfma16(ldsfrag(Ki + (32 * jb + fr) * RS + 16 * fq), Qf0, z4);
        s0 = mfma16(ldsfrag(Ki + (32 * jb + fr) * RS + 16 * fq + 64), Qf1, s0);
        f32x4 s1 = z4;
        if (2 * jb + 1 <= w) { s1 = mfma16(ldsfrag(Ki + (32 * jb + 16 + fr) * RS + 16 * fq), Qf0, z4); s1 = mfma16(ldsfrag(Ki + (32 * jb + 16 + fr) * RS + 16 * fq + 64), Qf1, s1); }
#pragma unroll
        for (int i = 0; i < 4; ++i) {
            const int d0 = (t0 + fr) - (32 * jb + 4 * fq + i), d1 = d0 - 16;
            s0[i] = d0 >= 0 ? s0[i] * exp2f((float)d0 * lg) : 0.f;
            s1[i] = d1 >= 0 ? s1[i] * exp2f((float)d1 * lg) : 0.f;
        }
        const bf16x8 Pf = pack8(s0, s1);
#pragma unroll
        for (int vt = 0; vt < 4; ++vt) O[vt] = mfma16(Pf, trfrag(Vi, 32 * jb + 4 * fq, 32 * jb + 16 + 4 * fq, 16 * vt, fr), O[vt]);
    }
#pragma unroll
    for (int vt = 0; vt < 4; ++vt) {
        f32x4 oi = mfma16(Qf0, ldsfrag(Si + (16 * vt + fr) * RS + 16 * fq), z4);
        oi = mfma16(Qf1, ldsfrag(Si + (16 * vt + fr) * RS + 16 * fq + 64), oi);
#pragma unroll
        for (int i = 0; i < 4; ++i) O[vt][i] = 0.125f * (O[vt][i] + exp2f((float)(t0 + 4 * fq + i + 1) * lg) * oi[i]);
    }
    bf16* Y = (bf16*)(C.ws + WS_Y);
#pragma unroll
    for (int i = 0; i < 4; ++i) {
        const float mu = sum16((O[0][i] + O[1][i]) + (O[2][i] + O[3][i])) * (1.f / 64.f);
        float q = 0.f;
#pragma unroll
        for (int vt = 0; vt < 4; ++vt) { const float d = O[vt][i] - mu; q += d * d; }
        const float rstd = 1.0f / sqrtf(sum16(q) * (1.f / 64.f) + EPS);
        const size_t row = rowbase + t0 + 4 * fq + i;
#pragma unroll
        for (int vt = 0; vt < 4; ++vt) {
            const int ch = h * 64 + 16 * vt + fr;
            const float g = bf2f(gq[i][vt]);
            const float y = ((O[vt][i] - mu) * rstd * pgw[vt] + pgb[vt]) * (g * sigmoidf_(g));
            Y[row * DM + 256 + ch] = (bf16)f2bf(y);
        }
    }
}

__device__ __forceinline__ void swa_unit_mfma(const Ctx& C, int l, int hb, int bl, int blk, int kvh) {
    LAS unsigned char* Ki = C.lds;
    LAS unsigned char* Vi = Ki + 256 * RS;
    const int tid = C.tid, lane = C.lane, w = C.wave, fr = lane & 15, fq = lane >> 4;
    u32x4 qraw[2][2];
#pragma unroll
    for (int tt = 0; tt < 2; ++tt) { const bf16* src = C.PROJ + bm_idx(bl * SEQ + blk * SEGL + 16 * ((w & 3) * 2 + tt) + fr, 2048 + (kvh * 2 + (w >> 2)) * 64 + 8 * fq);
        qraw[tt][0] = *(const u32x4*)src; qraw[tt][1] = *(const u32x4*)(src + 32); }
    u32x4 rk[4], rv[4];
#pragma unroll
    for (int i = 0; i < 4; ++i) {
        const int idx = tid + 512 * i, row = idx >> 3, c8 = idx & 7, pos = (blk - 1) * SEGL + row;
        const int pc = pos > 0 ? pos : 0;
        rk[i] = *(const u32x4*)(C.PROJ + bm_idx(bl * SEQ + pc, 2304 + kvh * 64 + 8 * c8)); rv[i] = *(const u32x4*)(C.PROJ + bm_idx(bl * SEQ + pc, 2432 + kvh * 64 + 8 * c8));
    }
    const f32x4 kw0 = *(const f32x4*)(C.PB + l * PB_N + PB_KN + 8 * (tid & 7)), kw1 = *(const f32x4*)(C.PB + l * PB_N + PB_KN + 8 * (tid & 7) + 4);
    const float* qn = C.PB + l * PB_N + PB_QN + 8 * fq;
    const f32x4 qw0 = *(const f32x4*)qn, qw1 = *(const f32x4*)(qn + 4), qw2 = *(const f32x4*)(qn + 32), qw3 = *(const f32x4*)(qn + 36);
    const float sink = C.PB[l * PB_N + PB_SINK + kvh * 2 + (w >> 2)];
    lds_barrier();
#pragma unroll
    for (int i = 0; i < 4; ++i) {
        const int idx = tid + 512 * i, row = idx >> 3, c8 = idx & 7;
        const bool zero = (blk - 1) * SEGL + row < 0;
        const u32x4 kv = zero ? (u32x4){0u, 0u, 0u, 0u} : rk[i], vv = zero ? (u32x4){0u, 0u, 0u, 0u} : rv[i];
        float f[8]; unpack8(kv, f);
        float ss = 0.f;
#pragma unroll
        for (int e = 0; e < 8; ++e) ss += f[e] * f[e];
        ss += swz_xor<1>(ss); ss += swz_xor<2>(ss); ss += swz_xor<4>(ss);
        const float r = 1.0f / sqrtf(ss * (1.f / 64.f) + EPS);
        const f32x4 w0 = kw0, w1 = kw1;
        u32x4 ko; ko.x = pkbf(f[0] * r * w0[0], f[1] * r * w0[1]); ko.y = pkbf(f[2] * r * w0[2], f[3] * r * w0[3]); ko.z = pkbf(f[4] * r * w1[0], f[5] * r * w1[1]); ko.w = pkbf(f[6] * r * w1[2], f[7] * r * w1[3]);
        *(LAS u32x4*)(Ki + row * RS + c8 * 16) = ko;
        *(LAS u32x4*)(Vi + row * RS + c8 * 16) = vv;
    }
    lds_barrier();
    const int g = w >> 2, h = kvh * 2 + g;
    const float slope = exp2f(-2.0f * (float)(h + 1));
    const f32x4 z4 = {0.f, 0.f, 0.f, 0.f};
    bf16* Y = (bf16*)(C.ws + WS_Y);
#pragma unroll 1
    for (int tt = 0; tt < 2; ++tt) {
        const int t0 = 16 * ((w & 3) * 2 + tt);
        const size_t qrow = (size_t)(bl * SEQ + blk * SEGL + t0);
        bf16x8 Qf0, Qf1;
        {
            float a[8], b[8]; unpack8(tt ? qraw[1][0] : qraw[0][0], a); unpack8(tt ? qraw[1][1] : qraw[0][1], b);
            float ss = 0.f;
#pragma unroll
            for (int e = 0; e < 8; ++e) ss += a[e] * a[e] + b[e] * b[e];
            ss = sum4g(ss, lane);
            const float r = 0.125f / sqrtf(ss * (1.f / 64.f) + EPS);
            const f32x4 w0 = qw0, w1 = qw1, w2 = qw2, w3 = qw3;
            u32x4 p; p.x = pkbf(a[0] * r * w0[0], a[1] * r * w0[1]); p.y = pkbf(a[2] * r * w0[2], a[3] * r * w0[3]); p.z = pkbf(a[4] * r * w1[0], a[5] * r * w1[1]); p.w = pkbf(a[6] * r * w1[2], a[7] * r * w1[3]);
            Qf0 = __builtin_bit_cast(bf16x8, p);
            p.x = pkbf(b[0] * r * w2[0], b[1] * r * w2[1]); p.y = pkbf(b[2] * r * w2[2], b[3] * r * w2[3]); p.z = pkbf(b[4] * r * w3[0], b[5] * r * w3[1]); p.w = pkbf(b[6] * r * w3[2], b[7] * r * w3[3]);
            Qf1 = __builtin_bit_cast(bf16x8, p);
        }
        const int jb0 = t0 >> 5;
        f32x4 s[10];
#pragma unroll
        for (int u = 0; u < 10; ++u) {
            const int jr = 32 * jb0 + 16 * u + fr;
            s[u] = mfma16(ldsfrag(Ki + jr * RS + 16 * fq), Qf0, z4);
            s[u] = mfma16(ldsfrag(Ki + jr * RS + 16 * fq + 64), Qf1, s[u]);
        }
        float m = sink;
        const unsigned dmax = blk > 0 ? 128u : (unsigned)(t0 + fr + 1);
#pragma unroll
        for (int u = 0; u < 10; ++u) {
#pragma unroll
            for (int i = 0; i < 4; ++i) {
                const int jl = 32 * jb0 + 16 * u + 4 * fq + i, dist = t0 + fr + 128 - jl;
                s[u][i] = (unsigned)dist < dmax ? s[u][i] - slope * (float)dist : -1e30f;
                m = fmaxf(m, s[u][i]);
            }
            __builtin_amdgcn_sched_barrier(0);
        }
        m = max4g(m, lane);
        float ls = 0.f;
#pragma unroll
        for (int u = 0; u < 10; ++u)
#pragma unroll
            for (int i = 0; i < 4; ++i) { const float p = __expf(s[u][i] - m); s[u][i] = p; ls += p; }
        ls = sum4g(ls, lane) + __expf(sink - m);
        const float inv = 1.0f / ls;
        f32x4 O[4] = {z4, z4, z4, z4};
#pragma unroll
        for (int jb = 0; jb < 5; ++jb) {
            const bf16x8 Pf = pack8(s[2 * jb] * inv, s[2 * jb + 1] * inv);
            const int j0 = 32 * (jb0 + jb) + 4 * fq;
#pragma unroll
            for (int vt = 0; vt < 4; ++vt) O[vt] = mfma16(Pf, trfrag(Vi, j0, j0 + 16, 16 * vt, fr), O[vt]);
        }
#pragma unroll
        for (int i = 0; i < 4; ++i)
#pragma unroll
            for (int vt = 0; vt < 4; ++vt) Y[(qrow + 4 * fq + i) * DM + 512 + h * 64 + 16 * vt + fr] = (bf16)f2bf(O[vt][i]);
    }
}

__device__ __forceinline__ float gelu_tanh(float x) { const float y = 0.7978845608028654f * (x + 0.044715f * x * x * x); const float t = 1.0f - 2.0f * __builtin_amdgcn_rcpf(1.0f + __expf(2.0f * y)); return 0.5f * x * (1.0f + t); }


struct HgRegs { u32x4 rq[2], rv[2]; float sv[8]; bf16 zr[16]; };
template <bool OUT>
__device__ __forceinline__ void hgrn_load(const Ctx& C, int bl, int seg, int h, HgRegs& R) {
    int tid = C.tid; asm volatile("" : "+v"(tid)); const int lane = tid & 63, w = C.wave; const size_t rowbase = (size_t)(bl * SEQ + seg * SEGL);
    const float* Sg = C.SH + ((size_t)((bl * NSEG + seg) * 4 + h)) * 4096;
#pragma unroll
    for (int i = 0; i < 2; ++i) {
        const int idx = tid + 512 * i, row = idx >> 3, c8 = idx & 7, prow = (int)rowbase + row;
        if (OUT) R.rq[i] = *(const u32x4*)(C.PROJ + bm_idx(prow, h * 64 + 8 * c8));
        R.rv[i] = *(const u32x4*)(C.PROJ + bm_idx(prow, 512 + h * 64 + 8 * c8));
    }
    if (OUT) {
#pragma unroll
        for (int e = 0; e < 8; ++e) R.sv[e] = Sg[(8 * (tid >> 6) + e) * 64 + (tid & 63)];
    }
    { const bf16* zs = C.PROJ + bm_idx((int)rowbase + 16 * w, 256 + h * 64 + lane);
#pragma unroll
      for (int t = 0; t < 16; ++t) R.zr[t] = zs[t * 64]; }
}
template <bool OUT>
__device__ __forceinline__ void hgrn_unit_mfma(const Ctx& C, int l, int hb, int bl, int seg, int h, HgRegs& R, bool hn, int un) {
    LAS unsigned char* Qi = C.lds;
    LAS unsigned char* Ki = Qi + 128 * RS;
    LAS unsigned char* Vi = Ki + 128 * RS;
    LAS float* BL = (LAS float*)(Vi + 128 * RS);
    LAS float* BO = BL + 128 * 68;
    LAS float* TT = BO + 512;
    LAS unsigned char* Si = (LAS unsigned char*)(TT + 512);
    const int tid = C.tid, lane = C.lane, w = C.wave, fr = lane & 15, fq = lane >> 4;
    const size_t rowbase = (size_t)(bl * SEQ + seg * SEGL);
    const float* PBL = C.PB + l * PB_N;
    float* Sg = C.SH + ((size_t)((bl * NSEG + seg) * 4 + h)) * 4096;
    u32x4 (&rq)[2] = R.rq; u32x4 (&rv)[2] = R.rv; float (&sv)[8] = R.sv;
    bf16 zr[16];
#pragma unroll
    for (int t = 0; t < 16; ++t) zr[t] = R.zr[t];
    const float lb = PBL[PB_LB + h * 64 + lane];
    lds_barrier();
#pragma unroll
    for (int i = 0; i < 2; ++i) {
        const int idx = tid + 512 * i, row = idx >> 3, c8 = idx & 7;
        if (OUT) *(LAS u32x4*)(Qi + row * RS + c8 * 16) = rq[i];
        *(LAS u32x4*)(Vi + row * RS + c8 * 16) = rv[i];
    }
    if (OUT) {
        const int v = tid & 63, kg = tid >> 6;
        u32x4 o; o.x = pkbf(sv[0], sv[1]); o.y = pkbf(sv[2], sv[3]); o.z = pkbf(sv[4], sv[5]); o.w = pkbf(sv[6], sv[7]);
        *(LAS u32x4*)(Si + v * RS + kg * 16) = o;
    }
    float kkv[16];
    {
        float cum = 0.f;
#pragma unroll
        for (int t = 0; t < 16; ++t) {
            const float sg = sigmoidf_(bf2f(zr[t])), f = fmaxf(lb, 1e-30f) + (1.f - lb) * sg;
            kkv[t] = (1.f - lb) * (1.f - sg);
            cum += __logf(f);
            BL[(16 * w + t) * 68 + lane] = cum;
            if (OUT) *(LAS bf16*)(Ki + (16 * w + t) * RS + 2 * lane) = (bf16)f2bf(kkv[t]);
        }
        TT[w * 64 + lane] = cum;
    }
    if (hn) hgrn_load<OUT>(C, un >> 7, (un >> 2) & 31, un & 3, R);
    lds_barrier();
    {   float bo = 0.f;
        for (int c = 0; c < w; ++c) bo += TT[c * 64 + lane];
        BO[w * 64 + lane] = bo;
        if (!OUT) {
            float tot = bo;
            for (int c = w; c < 8; ++c) tot += TT[c * 64 + lane];
#pragma unroll
            for (int t = 0; t < 16; ++t) *(LAS bf16*)(Ki + (16 * w + t) * RS + 2 * lane) = (bf16)f2bf(kkv[t] * __expf(tot - bo - BL[(16 * w + t) * 68 + lane]));
            if (w == 0) C.DH[((bl * NSEG + seg) * 4 + h) * 64 + lane] = __expf(tot);
        }
    }
    lds_barrier();
    const f32x4 z4 = {0.f, 0.f, 0.f, 0.f};
    if (!OUT) {
        const int kt = w >> 1, vt0 = (w & 1) * 2;
        f32x4 a0 = z4, a1 = z4;
#pragma unroll
        for (int jb = 0; jb < 4; ++jb) {
            const int j0 = 32 * jb + 8 * fq;
            const bf16x8 Af = trfrag(Ki, j0, j0 + 4, 16 * kt, fr);
            a0 = mfma16(Af, trfrag(Vi, j0, j0 + 4, 16 * vt0, fr), a0);
            a1 = mfma16(Af, trfrag(Vi, j0, j0 + 4, 16 * vt0 + 16, fr), a1);
        }
#pragma unroll
        for (int i = 0; i < 4; ++i) { Sg[(16 * kt + 4 * fq + i) * 64 + 16 * vt0 + fr] = a0[i]; Sg[(16 * kt + 4 * fq + i) * 64 + 16 * vt0 + 16 + fr] = a1[i]; }
        return;
    }
    const int c = w, t0 = 16 * c;
    float pow_[4];
#pragma unroll
    for (int vt = 0; vt < 4; ++vt) pow_[vt] = PBL[PB_HGN + h * 64 + 16 * vt + fr];
    bf16 gq[4][4];
#pragma unroll
    for (int i = 0; i < 4; ++i)
#pragma unroll
        for (int vt = 0; vt < 4; ++vt) gq[i][vt] = C.PROJ[bm_idx((int)rowbase + t0 + 4 * fq + i, 768 + h * 64 + 16 * vt + fr)];
    bf16x8 Qc[2], Qt[2], Qs[2];
    f32x4 bref[2][2], boc[2][2];
#pragma unroll
    for (int ks = 0; ks < 2; ++ks) {
        const int kx = 8 * fq + 32 * ks;
        float q[8]; unpack8(*(const LAS u32x4*)(Qi + (t0 + fr) * RS + 2 * kx), q);
        const f32x4 b0 = *(const LAS f32x4*)(BL + (t0 + fr) * 68 + kx), b1 = *(const LAS f32x4*)(BL + (t0 + fr) * 68 + kx + 4);
        bref[ks][0] = *(const LAS f32x4*)(BL + (t0 + 8) * 68 + kx); bref[ks][1] = *(const LAS f32x4*)(BL + (t0 + 8) * 68 + kx + 4);
        boc[ks][0] = *(const LAS f32x4*)(BO + c * 64 + kx); boc[ks][1] = *(const LAS f32x4*)(BO + c * 64 + kx + 4);
        f32x4 lo, hi;
#pragma unroll
        for (int e = 0; e < 4; ++e) { lo[e] = q[e] * __expf(b0[e]); hi[e] = q[4 + e] * __expf(b1[e]); }
        Qc[ks] = pack8(lo, hi);
#pragma unroll
        for (int e = 0; e < 4; ++e) { lo[e] = q[e] * __expf(b0[e] - bref[ks][0][e]); hi[e] = q[4 + e] * __expf(b1[e] - bref[ks][1][e]); }
        Qt[ks] = pack8(lo, hi);
#pragma unroll
        for (int e = 0; e < 4; ++e) { lo[e] = q[e] * __expf(boc[ks][0][e] + b0[e]); hi[e] = q[4 + e] * __expf(boc[ks][1][e] + b1[e]); }
        Qs[ks] = pack8(lo, hi);
    }
    f32x4 O[4] = {z4, z4, z4, z4};
    for (int jb = 0; jb <= (c >> 1); ++jb) {
        f32x4 st[2];
#pragma unroll
        for (int hf = 0; hf < 2; ++hf) {
            const int u = 2 * jb + hf;
            st[hf] = z4;
            if (u <= c) {
                const bool diag = (u == c);
#pragma unroll
                for (int ks = 0; ks < 2; ++ks) {
                    const int kx = 8 * fq + 32 * ks;
                    float k8[8]; unpack8(*(const LAS u32x4*)(Ki + (16 * u + fr) * RS + 2 * kx), k8);
                    const f32x4 b0 = *(const LAS f32x4*)(BL + (16 * u + fr) * 68 + kx), b1 = *(const LAS f32x4*)(BL + (16 * u + fr) * 68 + kx + 4);
                    f32x4 e0, e1;
                    if (diag) { e0 = bref[ks][0] - b0; e1 = bref[ks][1] - b1; }
                    else { e0 = boc[ks][0] - *(const LAS f32x4*)(BO + u * 64 + kx) - b0; e1 = boc[ks][1] - *(const LAS f32x4*)(BO + u * 64 + kx + 4) - b1; }
                    f32x4 lo, hi;
#pragma unroll
                    for (int e = 0; e < 4; ++e) { lo[e] = k8[e] * __expf(e0[e]); hi[e] = k8[4 + e] * __expf(e1[e]); }
                    st[hf] = mfma16(pack8(lo, hi), diag ? Qt[ks] : Qc[ks], st[hf]);
                }
                if (diag) {
#pragma unroll
                    for (int i = 0; i < 4; ++i) st[hf][i] = (4 * fq + i <= fr) ? st[hf][i] : 0.f;
                }
            }
        }
        const bf16x8 Pf = pack8(st[0], st[1]);
#pragma unroll
        for (int vt = 0; vt < 4; ++vt) O[vt] = mfma16(Pf, trfrag(Vi, 32 * jb + 4 * fq, 32 * jb + 16 + 4 * fq, 16 * vt, fr), O[vt]);
    }
#pragma unroll
    for (int vt = 0; vt < 4; ++vt) {
        O[vt] = mfma16(Qs[0], ldsfrag(Si + (16 * vt + fr) * RS + 16 * fq), O[vt]);
        O[vt] = mfma16(Qs[1], ldsfrag(Si + (16 * vt + fr) * RS + 16 * fq + 64), O[vt]);
    }
    bf16* Y = (bf16*)(C.ws + WS_Y);
    int fqe = fq; asm volatile("" : "+v"(fqe));
#pragma unroll
    for (int i = 0; i < 4; ++i) {
        const float ms = sum16((O[0][i] * O[0][i] + O[1][i] * O[1][i]) + (O[2][i] * O[2][i] + O[3][i] * O[3][i])) * (1.f / 64.f);
        const float rstd = 1.0f / sqrtf(ms + EPS);
        const size_t row = rowbase + t0 + 4 * fqe + i;
#pragma unroll
        for (int vt = 0; vt < 4; ++vt) {
            const int ch = h * 64 + 16 * vt + fr;
            const float g = bf2f(gq[i][vt]);
            Y[row * DM + ch] = (bf16)f2bf(O[vt][i] * rstd * pow_[vt] * sigmoidf_(g));
        }
    }
}

constexpr int LRU_PB_OFF = 114688;
struct LruRegs { u32x4 xr[3]; float gv[16]; };
__device__ __forceinline__ void lru_params_to_lds(const Ctx& C, int l, int n) {
    LAS unsigned char* P = C.lds + LRU_PB_OFF; LAS float* PF = (LAS float*)(P + 2 * 64 * RS);
    const bf16* WT = C.W + (size_t)l * E_LAYER + O_WLRU;
    const float* PBL = C.PB + l * PB_N;
    lds_barrier();
    for (int idx = C.tid; idx < 2 * 64 * 8; idx += 512) { const int gate = idx >> 9, e = (idx >> 3) & 63, c8 = idx & 7;
        *(LAS u32x4*)(P + (gate * 64 + e) * RS + c8 * 16) = *(const u32x4*)(WT + ((size_t)(gate * 4 + n) * 64 + e) * 64 + 8 * c8); }
    if (C.tid < 256) PF[C.tid] = PBL[PB_CW + (C.tid >> 6) * 256 + n * 64 + (C.tid & 63)];
    else { const int k = (C.tid - 256) >> 6, c = C.tid & 63; PF[256 + k * 64 + c] = PBL[(k == 0 ? PB_CB : k == 1 ? PB_BA : k == 2 ? PB_BX : PB_SP) + n * 64 + c]; }
    lds_barrier();
}
template <bool OUT>
__device__ __forceinline__ void lru_load(const Ctx& C, int bl, int seg, int n, LruRegs& R) {
    int tid = C.tid; asm volatile("" : "+v"(tid)); const int lane = tid & 63, w = C.wave; const size_t rowbase = (size_t)(bl * SEQ + seg * SEGL);
    if (OUT) { const bf16* gp = C.PROJ + bm_idx((int)rowbase + 16 * w, 2816 + n * 64 + lane);
#pragma unroll
        for (int t = 0; t < 16; ++t) R.gv[t] = bf2f(gp[t * 64]); }
#pragma unroll
    for (int i = 0; i < 3; ++i) { const int idx = tid + 512 * i, r = (idx >> 3) < 130 ? (idx >> 3) : 130, c8 = idx & 7, t_abs = seg * SEGL - 3 + r;
        R.xr[i] = *(const u32x4*)(C.PROJ + bm_idx(bl * SEQ + (t_abs > 0 ? t_abs : 0), 2560 + n * 64 + 8 * c8)); }
}
template <bool OUT>
__device__ __forceinline__ void lru_unit_mfma(const Ctx& C, int l, int hb, int bl, int seg, int n, LruRegs& R, bool hn, int un) {
    LAS unsigned char* Xi = C.lds;
    LAS unsigned char* XCi = Xi + 132 * RS;
    LAS float* A = (LAS float*)(XCi + 128 * RS);
    LAS float* U = A + 128 * 68;
    LAS float* PC = U + 128 * 68;
    LAS float* HC = PC + 512;
    const int tid = C.tid, lane = C.lane, w = C.wave, fr = lane & 15, fq = lane >> 4;
    const size_t rowbase = (size_t)(bl * SEQ + seg * SEGL);
    if (C.G & 3) lru_params_to_lds(C, l, n);
    const LAS unsigned char* PP = C.lds + LRU_PB_OFF; const LAS float* PF = (const LAS float*)(PP + 2 * 64 * RS);
    float gv[16];
#pragma unroll
    for (int t = 0; t < 16; ++t) gv[t] = OUT ? R.gv[t] : 0.f;
    u32x4 (&xr)[3] = R.xr;
    lds_barrier();
#pragma unroll
    for (int i = 0; i < 3; ++i) { const int idx = tid + 512 * i, r = idx >> 3, c8 = idx & 7; const bool zero = seg * SEGL - 3 + r < 0;
        if (idx < 131 * 8) *(LAS u32x4*)(Xi + r * RS + c8 * 16) = zero ? (u32x4){0u, 0u, 0u, 0u} : xr[i]; }
    if (hn) lru_load<OUT>(C, un >> 7, (un >> 2) & 31, un & 3, R);
    lds_barrier();
    {
        const int t = tid >> 2, c16 = (tid & 3) * 16;
        float acc[16];
#pragma unroll
        for (int e4 = 0; e4 < 4; ++e4) { const f32x4 b = *(const LAS f32x4*)(PF + 256 + c16 + 4 * e4); acc[4 * e4] = b[0]; acc[4 * e4 + 1] = b[1]; acc[4 * e4 + 2] = b[2]; acc[4 * e4 + 3] = b[3]; }
#pragma unroll
        for (int j = 0; j < 4; ++j) {
            float x[16]; unpack8(*(const LAS u32x4*)(Xi + (t + j) * RS + 2 * c16), x); unpack8(*(const LAS u32x4*)(Xi + (t + j) * RS + 2 * c16 + 16), x + 8);
#pragma unroll
            for (int e4 = 0; e4 < 4; ++e4) { const f32x4 wv = *(const LAS f32x4*)(PF + j * 64 + c16 + 4 * e4);
                acc[4 * e4] += wv[0] * x[4 * e4]; acc[4 * e4 + 1] += wv[1] * x[4 * e4 + 1]; acc[4 * e4 + 2] += wv[2] * x[4 * e4 + 2]; acc[4 * e4 + 3] += wv[3] * x[4 * e4 + 3]; }
        }
        u32x4 o0, o1; o0.x = pkbf(acc[0], acc[1]); o0.y = pkbf(acc[2], acc[3]); o0.z = pkbf(acc[4], acc[5]); o0.w = pkbf(acc[6], acc[7]);
        o1.x = pkbf(acc[8], acc[9]); o1.y = pkbf(acc[10], acc[11]); o1.z = pkbf(acc[12], acc[13]); o1.w = pkbf(acc[14], acc[15]);
        *(LAS u32x4*)(XCi + t * RS + 2 * c16) = o0; *(LAS u32x4*)(XCi + t * RS + 2 * c16 + 16) = o1;
    }
    lds_barrier();
    {
        const f32x4 z4 = {0.f, 0.f, 0.f, 0.f};
        const bf16x8 Xf0 = ldsfrag(XCi + (16 * w + fr) * RS + 16 * fq), Xf1 = ldsfrag(XCi + (16 * w + fr) * RS + 16 * fq + 64);
#pragma unroll
        for (int et = 0; et < 4; ++et) {
            const int e = 16 * et + fr;
            const LAS unsigned char* wa = PP + (0 * 64 + e) * RS + 16 * fq;
            const LAS unsigned char* wx = PP + (1 * 64 + e) * RS + 16 * fq;
            f32x4 ra = mfma16(Xf0, ldsfrag(wa), z4); ra = mfma16(Xf1, ldsfrag(wa + 64), ra);
            f32x4 ia = mfma16(Xf0, ldsfrag(wx), z4); ia = mfma16(Xf1, ldsfrag(wx + 64), ia);
            const float ba = PF[256 + 64 + e], bx = PF[256 + 128 + e], sp = PF[256 + 192 + e];
#pragma unroll
            for (int i = 0; i < 4; ++i) {
                const int t = 16 * w + 4 * fq + i;
                const float r = sigmoidf_(ra[i] + ba), ig = sigmoidf_(ia[i] + bx), xc = bf2f(*(const LAS bf16*)(XCi + t * RS + 2 * e));
                const float la = -8.0f * r * sp;
                A[t * 68 + e] = __expf(la);
                const float x2 = 2.0f * la;
                const float om = x2 > -0.25f ? -x2 * (1.0f + x2 * (0.5f + x2 * (0.16666667f + x2 * (0.041666668f + x2 * 0.0083333338f)))) : 1.0f - __expf(x2);
                U[t * 68 + e] = __builtin_amdgcn_sqrtf(om) * (ig * xc);
            }
        }
    }
    lds_barrier();
    {
        float P = 1.f, hl = 0.f;
#pragma unroll
        for (int t = 0; t < 16; ++t) { const float a = A[(16 * w + t) * 68 + lane], u = U[(16 * w + t) * 68 + lane]; hl = a * hl + u; P *= a; }
        PC[w * 64 + lane] = P; HC[w * 64 + lane] = hl;
    }
    lds_barrier();
    const int sidx = (bl * NSEG + seg) * 256 + n * 64 + lane;
    if (!OUT) {
        if (w == 0) { float hh = 0.f, P = 1.f;
#pragma unroll
            for (int c = 0; c < 8; ++c) { hh = PC[c * 64 + lane] * hh + HC[c * 64 + lane]; P *= PC[c * 64 + lane]; }
            C.HEND[sidx] = hh; C.PEND[sidx] = P; }
        return;
    }
    float hh = C.HEND[sidx];
    for (int c = 0; c < w; ++c) hh = PC[c * 64 + lane] * hh + HC[c * 64 + lane];
    bf16* Y = (bf16*)(C.ws + WS_Y);
#pragma unroll
    for (int t = 0; t < 16; ++t) {
        hh = A[(16 * w + t) * 68 + lane] * hh + U[(16 * w + t) * 68 + lane];
        Y[(rowbase + 16 * w + t) * DM + 768 + n * 64 + lane] = (bf16)f2bf(hh * gelu_tanh(gv[t]));
    }
}

__device__ __forceinline__ float wave_max(float v, int lane) {
    v = fmaxf(v, swz_xor<1>(v)); v = fmaxf(v, swz_xor<2>(v)); v = fmaxf(v, swz_xor<4>(v)); v = fmaxf(v, swz_xor<8>(v)); v = fmaxf(v, swz_xor<16>(v));
    return fmaxf(v, __int_as_float(__builtin_amdgcn_ds_bpermute((lane ^ 32) << 2, __float_as_int(v))));
}
__device__ __forceinline__ unsigned q4(float a, float b, float c, float d) {
    unsigned w = 0u;
    w = __builtin_amdgcn_cvt_pk_u8_f32(a + 128.0f, 0, w); w = __builtin_amdgcn_cvt_pk_u8_f32(b + 128.0f, 1, w); w = __builtin_amdgcn_cvt_pk_u8_f32(c + 128.0f, 2, w); w = __builtin_amdgcn_cvt_pk_u8_f32(d + 128.0f, 3, w);
    return w ^ 0x80808080u;
}
template <bool WITH_W>
__device__ __forceinline__ void quant_rows(const Ctx& C) {
    constexpr int NR = MT + (WITH_W ? DEPTH * QW_L : 0), RPT = 6;
    const int gw = C.bid * 8 + C.wave, NGW = C.G * 8;
    unsigned char* XQ = C.ws + WS_XQ; float* rowf = (float*)(C.ws + WS_ROWF); float* csc = (float*)(C.ws + WS_CSC);
#pragma unroll 1
    for (int m0 = gw; m0 < NR; m0 += RPT * NGW) {
        u32x4 v[RPT][2];
#pragma unroll
        for (int rr = 0; rr < RPT; ++rr) { int r = m0 + rr * NGW; r = r < NR ? r : NR - 1;
            const bf16* src = C.HN + (size_t)r * DM;
            if (WITH_W && r >= MT) { const int w = r - MT, wl = w / QW_L, o = w % QW_L;
                src = C.W + (size_t)wl * E_LAYER + (o < QW_G ? O_WGU1 + (size_t)o * DM : o < QW_GU2 ? O_WIN + (size_t)(NPROJ + o - QW_G) * DM : O_WGU2 + (size_t)(o - QW_GU2) * DM); }
            v[rr][0] = ((const u32x4*)src)[C.lane]; v[rr][1] = ((const u32x4*)src)[C.lane + 64]; }
#pragma unroll
        for (int rr = 0; rr < RPT; ++rr) { const int r = m0 + rr * NGW;
            if (r < NR) {
                float x[16]; unpack8(v[rr][0], x); unpack8(v[rr][1], x + 8);
                float a = 0.f, q = 0.f;
#pragma unroll
                for (int e = 0; e < 16; ++e) { a = fmaxf(a, fabsf(x[e])); q += x[e] * x[e]; }
                a = wave_max(a, C.lane); q = wave_sum(q, C.lane);
                const float inv = a > 0.f ? 127.0f / a : 0.f, s = a * (1.0f / 127.0f);
#pragma unroll
                for (int e = 0; e < 16; ++e) x[e] = rintf(x[e] * inv);
                unsigned char* dst = XQ + (size_t)r * DM;
                if (WITH_W && r >= MT) { const int w = r - MT, wl = w / QW_L, o = w % QW_L;
                    dst = (unsigned char*)(C.W + (size_t)wl * E_LAYER + (o < QW_G ? O_WGU1 + (size_t)o * DM : o < QW_GU2 ? O_WIN + (size_t)(NPROJ + o - QW_G) * DM : O_WGU2 + (size_t)(o - QW_GU2) * DM)); }
                ((u32x2*)dst)[C.lane] = (u32x2){q4(x[0], x[1], x[2], x[3]), q4(x[4], x[5], x[6], x[7])};
                ((u32x2*)dst)[C.lane + 64] = (u32x2){q4(x[8], x[9], x[10], x[11]), q4(x[12], x[13], x[14], x[15])};
                if (C.lane == 0) { if (r < MT) rowf[r] = s / sqrtf(q * (1.f / DM) + EPS); else csc[r - MT] = s; }
            }
        }
    }
}

#define UNIT_LOOP(Regs, loadf, unitf) { Regs R; int u = C.bid; if (u < BATCH * 128) loadf(C, u >> 7, (u >> 2) & 31, u & 3, R); \
    for (; u < BATCH * 128; u += C.G) { const int un = u + C.G; unitf(C, l, hb, u >> 7, (u >> 2) & 31, u & 3, R, un < BATCH * 128, un); } }
__device__ __forceinline__ void mix_local_phase(const Ctx& C, int l, int hb) {
    quant_rows<false>(C);
    UNIT_LOOP(HgRegs, hgrn_load<false>, hgrn_unit_mfma<false>)
    UNIT_LOOP(RetRegs, ret_load<false>, ret_unit_mfma<false>)
    lru_params_to_lds(C, l, C.bid & 3);
    UNIT_LOOP(LruRegs, lru_load<false>, lru_unit_mfma<false>)
}
__device__ __forceinline__ void mix_scan_phase(const Ctx& C, int l, int hb) {
    for (int gi = C.bid * 512 + C.tid; gi < 2 * BH * 16384; gi += C.G * 512) {
        const int mixer = gi / (BH * 16384), e = gi % (BH * 16384), bl = e >> 14, hh = (e >> 12) & 3, kv = e & 4095, k = kv >> 6;
        float* S = (mixer == 0 ? C.SH : C.SR) + ((size_t)(bl * NSEG * 4 + hh)) * 4096 + kv;
        const float* D = C.DH + (bl * NSEG * 4 + hh) * 64 + k;
        float g128 = 1.0f - exp2f(-5.0f - (float)hh);
#pragma unroll
        for (int i = 0; i < 7; ++i) g128 *= g128;
        float sl[NSEG], dd[NSEG];
#pragma unroll
        for (int seg = 0; seg < NSEG; ++seg) { sl[seg] = S[(size_t)seg * 4 * 4096]; dd[seg] = mixer == 0 ? D[seg * 4 * 64] : g128; }
        float carry = 0.f;
#pragma unroll
        for (int seg = 0; seg < NSEG; ++seg) { S[(size_t)seg * 4 * 4096] = carry; carry = dd[seg] * carry + sl[seg]; }
    }
    for (int gi = C.bid * 512 + C.tid; gi < BH * 256; gi += C.G * 512) {
        const int bl = gi >> 8, c = gi & 255; float he[NSEG], pe[NSEG];
#pragma unroll
        for (int seg = 0; seg < NSEG; ++seg) { he[seg] = C.HEND[(bl * NSEG + seg) * 256 + c]; pe[seg] = C.PEND[(bl * NSEG + seg) * 256 + c]; }
        float carry = 0.f;
#pragma unroll
        for (int seg = 0; seg < NSEG; ++seg) { C.HEND[(bl * NSEG + seg) * 256 + c] = carry; carry = pe[seg] * carry + he[seg]; }
    }
    for (int u = C.bid; u < BATCH * 64; u += C.G) swa_unit_mfma(C, l, hb, u >> 6, (u >> 1) & 31, u & 1);
}
__device__ __forceinline__ void mix_out_phase(const Ctx& C, int l, int hb) {
    UNIT_LOOP(HgRegs, hgrn_load<true>, hgrn_unit_mfma<true>)
    UNIT_LOOP(RetRegs, ret_load<true>, ret_unit_mfma<true>)
    lru_params_to_lds(C, l, C.bid & 3);
    UNIT_LOOP(LruRegs, lru_load<true>, lru_unit_mfma<true>)
}

__global__ void __launch_bounds__(512, 2) fwd(Args args) {
    extern __shared__ __attribute__((aligned(16))) unsigned char lds_raw[];
    Ctx K;
    K.lds = (LAS unsigned char*)lds_raw;
    K.tid = 0; K.lane = 0; K.wave = __builtin_amdgcn_readfirstlane(threadIdx.x >> 6); K.G = gridDim.x; K.bid = blockIdx.x;
    K.in.t = (InTab)__builtin_amdgcn_kernarg_segment_ptr(); K.out = args.out; K.ws = args.ws;
    volatile LAS unsigned* MISC = (volatile LAS unsigned*)(K.lds + LDSCTL_OFF);
    if (threadIdx.x < 64) MISC[threadIdx.x] = 0u;
    __syncthreads();
    const int lo = args.ph_lo, hi = args.ph_hi;
    XcdBarrier bar; bar.bar = (unsigned*)(args.ws + WS_CTL) + CW_BAR; bar.x = 0; bar.st = MISC + 8; bar.wave = K.wave;
    if (hi - lo > 1) bar = xcd_barrier_post((unsigned*)(args.ws + WS_CTL) + CW_BAR, MISC + 8, K.wave);
    int ph = 0;
#define PH_BEGIN if (ph >= lo && ph < hi) { const Ctx C = phase_ctx(K);
#define PH_END   if (ph + 1 < hi) xcd_barrier(bar); } ++ph;

    PH_BEGIN
        LAS float* scr = (LAS float*)(C.lds + C.wave * 16384);
        const int gw = C.bid * 8 + C.wave, NGW = C.G * 8;
        {
            float ra[32], rb[32];
            int it = gw; ItemDesc da = decode_item(C, it < DEPTH * IT_LAYER ? it : 0), db = da;
            if (it < DEPTH * IT_LAYER) tr_load(da, ra, C.lane);
#pragma unroll 1
            while (it < DEPTH * IT_LAYER) {
                const int i1 = it + NGW, i2 = it + 2 * NGW;
                if (i1 < DEPTH * IT_LAYER) { db = decode_item(C, i1); tr_load(db, rb, C.lane); }
                tr_finish(da, ra, scr, C.lane);
                if (i1 >= DEPTH * IT_LAYER) break;
                if (i2 < DEPTH * IT_LAYER) { da = decode_item(C, i2); tr_load(da, ra, C.lane); }
                tr_finish(db, rb, scr, C.lane);
                it = i2;
            }
        }
        for (int e = C.bid * 512 + C.tid; e < DEPTH * PB_N; e += C.G * 512) {
            const int pl = e / PB_N, o = e % PB_N; float v = 0.f;
            if (o < 256) v = C.in[I_HGN][pl * 256 + o];
            else if (o < 512) v = C.in[I_RGW][pl * 256 + o - 256];
            else if (o < 768) v = C.in[I_RGB][pl * 256 + o - 512];
            else if (o < 832) v = C.in[I_QN][pl * 64 + o - 768];
            else if (o < 896) v = C.in[I_KN][pl * 64 + o - 832];
            else if (o < 900) v = C.in[I_SINK][pl * 4 + o - 896];
            else if (o < 1024) v = 0.f;
            else if (o < 2048) v = C.in[I_CW][pl * 1024 + o - 1024];
            else if (o < 2304) v = C.in[I_CB][pl * 256 + o - 2048];
            else if (o < 2560) v = C.in[I_BA][pl * 256 + o - 2304];
            else if (o < 2816) v = C.in[I_BX][pl * 256 + o - 2560];
            else if (o < 3072) v = log1pf(expf(-C.in[I_LAM][pl * 256 + o - 2816]));
            else if (o < 3328) v = hgrn_lb(C.in[I_LBL], pl, o - 3072);
            else if (o < 4096) v = 0.f;
            else v = C.in[I_GBIAS][pl * 4096 + o - 4096];
            C.PB[e] = v;
        }
        for (int e = C.bid * 512 + C.tid; e < DEPTH * (int)E_WLRU; e += C.G * 512) {
            const int pl = e / (int)E_WLRU, o = e % (int)E_WLRU, gate = o >> 14, n = (o >> 12) & 3, ee = (o >> 6) & 63, c = o & 63;
            const float v = (gate ? C.in[I_WX] : C.in[I_WA])[((size_t)(pl * 4 + n) * 64 + c) * 64 + ee];
            (C.W + (size_t)pl * E_LAYER + O_WLRU)[o] = (bf16)f2bf(v);
        }
        {
            float* ssq0 = (float*)(C.ws + WS_SSQ);
            for (int m = gw; m < MT; m += 4 * NGW) {
                f32x4 v[4][4];
#pragma unroll
                for (int rr = 0; rr < 4; ++rr)
#pragma unroll
                    for (int j = 0; j < 4; ++j) v[rr][j] = ((const f32x4*)(C.in[I_X] + (size_t)(m + rr * NGW) * DM) + C.lane)[64 * j];
#pragma unroll
                for (int rr = 0; rr < 4; ++rr) {
                    const int mm = m + rr * NGW; unsigned long long* o8 = (unsigned long long*)(C.HN + (size_t)mm * DM) + C.lane; float q = 0.f;
#pragma unroll
                    for (int j = 0; j < 4; ++j) { const f32x4 x = v[rr][j]; q += (x.x * x.x + x.y * x.y) + (x.z * x.z + x.w * x.w); o8[64 * j] = (unsigned long long)pk2(x.x, x.y) | ((unsigned long long)pk2(x.z, x.w) << 32); }
                    q = wave_sum(q, C.lane);
                    if (C.lane < 16) ssq0[(size_t)mm * 16 + C.lane] = C.lane == 0 ? q : 0.f;
                }
            }
        }
    PH_END

#pragma unroll 1
    for (int l = 0; l < DEPTH; ++l) {
#pragma unroll 1
        for (int f = 0; f < 2; ++f) {
            PH_BEGIN
                if (l == 0 && f == 0) quant_rows<true>(C); else quant_rows<false>(C);
            PH_END
            PH_BEGIN
#ifndef NO_UP
                pg8::Gemm g{DM / 2, DM, DM / 2}; pg8::StaticOrder S; S.init(MT, NGU, C.G, C.bid, C.ws + WS_XQ, DM / 2, C.W + (size_t)l * E_LAYER + (f == 0 ? O_WGU1 : O_WGU2), DM);
                pg8::EpiSwiglu8 E{C.ws, (unsigned)(l * QW_L + (f == 0 ? QW_GU1 : QW_GU2))};
                pg8::gemm_phase<pg8::EpiSwiglu8, pg8::StaticOrder, true>(C.lds, C.tid, g, S, E);
#endif
            PH_END
            PH_BEGIN
#ifndef NO_DOWN
                pg8::Gemm g{DFF, DFF, DFF}; pg8::StaticOrder S; S.init(MT, DM, C.G, C.bid, C.HID, DFF, C.W + (size_t)l * E_LAYER + (f == 0 ? O_WD1 : O_WD2), DFF);
                const bool fin = (f == 1) && (l + 1 == DEPTH);
                pg8::EpiResid E{C.out, 0.5f, C.ws, 0u, (unsigned)((l * 3 + 1) * MT), f == 0, fin};
                pg8::gemm_phase<pg8::EpiResid, pg8::StaticOrder, true>(C.lds, C.tid, g, S, E);
#endif
            PH_END
            if (f == 0) {
                const int hb = 0;
                PH_BEGIN
#ifndef NO_WIN
                    pg8::Gemm g{DM, DM, DM}; pg8::StaticOrder S; S.init(MT, NPROJ, C.G, C.bid, C.HN, DM, C.W + (size_t)l * E_LAYER + O_WIN, DM);
                    pg8::EpiWin E{C.ws, (unsigned)(l * PB_N + PB_GB), (unsigned)((l * 3 + 1) * MT), false};
                    pg8::gemm_phase<pg8::EpiWin, pg8::StaticOrder, true>(C.lds, C.tid, g, S, E);
#endif
                PH_END
                PH_BEGIN
                    mix_local_phase(C, l, hb);
                PH_END
                PH_BEGIN
                    mix_scan_phase(C, l, hb);
                PH_END
                PH_BEGIN
                    mix_out_phase(C, l, hb);
                PH_END
                PH_BEGIN
#ifndef NO_WIN
                    pg8::Gemm g{DM / 2, DM, DM / 2}; pg8::StaticOrder S; S.init(MT, NGATE, C.G, C.bid, C.ws + WS_XQ, DM / 2, C.W + (size_t)l * E_LAYER + O_WIN + (size_t)NPROJ * DM, DM);
                    pg8::EpiGate8 E{C.ws, (unsigned)(l * PB_N + PB_GB), (unsigned)(l * QW_L + QW_G)};
                    pg8::gemm_phase<pg8::EpiGate8, pg8::StaticOrder, true>(C.lds, C.tid, g, S, E);
#endif
                PH_END
                PH_BEGIN
#ifndef NO_MERGE
                    pg8::Gemm g{DM, DM, DM}; pg8::MergeOrder S; S.init(MT, C.G, C.bid, C.ws + WS_Y, C.W + (size_t)l * E_LAYER + O_WB);
                    pg8::EpiMerge E{C.ws};
                    pg8::gemm_phase<pg8::EpiMerge, pg8::MergeOrder, true, true>(C.lds, C.tid, g, S, E);
#endif
                PH_END
                PH_BEGIN
#ifndef NO_WOUT
                    pg8::Gemm g{DM, DM, DM}; pg8::StaticOrder S; S.init(MT, DM, C.G, C.bid, C.MERGED, DM, C.W + (size_t)l * E_LAYER + O_WOUT, DM);
                    pg8::EpiResid E{C.out, 1.0f, C.ws, 0u, 0u, false, false};
                    pg8::gemm_phase<pg8::EpiResid, pg8::StaticOrder, true>(C.lds, C.tid, g, S, E);
#endif
                PH_END
            }
        }
    }
#undef PH_BEGIN
#undef PH_END
}
constexpr int N_PHASES = 1 + DEPTH * (3 + 7 + 3);

extern "C" void kernel_launch(void* const* d_in, const int* in_sizes, int n_in, void* d_out, int out_size, void* d_ws, size_t ws_size, hipStream_t stream) {
    static int grid = 0;
    if (grid == 0) {
        if (n_in != 28 || in_sizes[0] != MT * DM || out_size != MT * DM || ws_size < WS_END3) { fprintf(stderr, "kernel_launch: unexpected shapes (n_in %d, x %d, out %d, ws %zu < %zu); nothing launched\n", n_in, n_in > 0 ? in_sizes[0] : -1, out_size, ws_size, (size_t)WS_END3); grid = -1; return; }
        int dev = 0, cus = 0, per_cu = 0;
        if (hipGetDevice(&dev) != hipSuccess || hipDeviceGetAttribute(&cus, hipDeviceAttributeMultiprocessorCount, dev) != hipSuccess) { grid = -1; return; }
        if (hipFuncSetAttribute((const void*)fwd, hipFuncAttributeMaxDynamicSharedMemorySize, LDS_BYTES) != hipSuccess) { fprintf(stderr, "kernel_launch: hipFuncSetAttribute failed\n"); grid = -1; return; }
        if (hipOccupancyMaxActiveBlocksPerMultiprocessor(&per_cu, (const void*)fwd, 512, LDS_BYTES) != hipSuccess || per_cu < 1) fprintf(stderr, "kernel_launch: occupancy query reports %d\n", per_cu);
        (void)hipGetLastError();
        grid = cus;
    }
    if (grid < 0) return;
    (void)hipMemsetAsync((char*)d_ws + WS_CTL, 0, CTL_ZERO_BYTES, stream);
    Args a{};
    for (int i = 0; i < 28; ++i) a.in[i] = (const float*)d_in[i];
    a.out = (float*)d_out; a.ws = (unsigned char*)d_ws;
#if MK_MULTI
    for (int p = 0; p < N_PHASES; ++p) { a.ph_lo = p; a.ph_hi = p + 1; hipLaunchKernelGGL(fwd, dim3(grid), dim3(512), LDS_BYTES, stream, a); }
#else
    a.ph_lo = 0; a.ph_hi = N_PHASES;
    hipLaunchKernelGGL(fwd, dim3(grid), dim3(512), LDS_BYTES, stream, a);
#endif
}
```
